# Optimizing an MI355X kernel written in HIP

```python
import math
import jax
import jax.numpy as jnp
from jax import lax
import numpy as np


D_MODEL = 1024
BATCH = 4
SEQ = 8192
DEPTH = 2

N_META = 16
BLOCK = 128
N_FRONT = BLOCK - N_META
ROPE_THETA = 500000.0
ROT_FRAC_DIV = 4
EPS = 1e-6
NEG_INF = -1e30
D_FF = 2816

DIFF_HEADS = 4
DIFF_HEAD_DIM = 64
DIFF_V_DIM = 2 * DIFF_HEAD_DIM
DIFF_EPS = 1e-5
MLA_HEADS = 4
MLA_NOPE = 128
MLA_ROPE = 64
MLA_V = 128
MLA_Q_RANK = 256
MLA_KV_RANK = 256
SWA_HEADS = 16
SWA_KV_HEADS = 2
SWA_GROUP = SWA_HEADS // SWA_KV_HEADS
SWA_HEAD_DIM = 64
WINDOW = 128

N_EVEN = (DEPTH + 1) // 2
N_ODD = DEPTH // 2

DIFF_QK_COLS = DIFF_HEADS * 2 * DIFF_HEAD_DIM
DIFF_V_COLS = DIFF_HEADS * DIFF_V_DIM
AB_SPLITS = (DIFF_QK_COLS,
             2 * DIFF_QK_COLS,
             2 * DIFF_QK_COLS + DIFF_V_COLS,
             2 * DIFF_QK_COLS + DIFF_V_COLS + MLA_Q_RANK,
             2 * DIFF_QK_COLS + DIFF_V_COLS + MLA_Q_RANK + MLA_KV_RANK)
AB_IN_COLS = AB_SPLITS[-1] + MLA_ROPE
AB_OUT_COLS = DIFF_V_COLS + MLA_HEADS * MLA_V
SWA_Q_COLS = SWA_HEADS * SWA_HEAD_DIM
SWA_KV_COLS = SWA_KV_HEADS * SWA_HEAD_DIM
SWA_IN_COLS = SWA_Q_COLS + 2 * SWA_KV_COLS

kernel_name = "hybrid_diffattn_mla_swa_macaron"


def rms_norm(x, g, eps=EPS):
    xf = x.astype(jnp.float32)
    y = xf * lax.rsqrt(jnp.mean(xf * xf, axis=-1, keepdims=True) + eps)
    return (y * g.astype(jnp.float32)).astype(x.dtype)


def rope_tables(pos, rot_dim):
    inv = ROPE_THETA ** (-jnp.arange(0, rot_dim, 2, dtype=jnp.float32) / rot_dim)
    ang = pos.astype(jnp.float32)[:, None] * inv[None, :]
    return jnp.cos(ang), jnp.sin(ang)


def apply_rope(x, cos, sin):
    half = x.shape[-1] // 2
    x1 = x[..., :half].astype(jnp.float32)
    x2 = x[..., half:].astype(jnp.float32)
    return jnp.concatenate([x1 * cos - x2 * sin, x2 * cos + x1 * sin], axis=-1).astype(x.dtype)


def partial_rope(x, cos, sin):
    r = x.shape[-1] // ROT_FRAC_DIV
    return jnp.concatenate([apply_rope(x[..., :r], cos, sin), x[..., r:]], axis=-1)


def swiglu(x, w_gate, w_up, w_down):
    return (jax.nn.silu(x @ w_gate) * (x @ w_up)) @ w_down


def to_blocks(a):
    b, l = a.shape[:2]
    return jnp.moveaxis(a.reshape((b, l // BLOCK, BLOCK) + a.shape[2:]), 1, 0)


def from_blocks(a):
    a = jnp.moveaxis(a, 0, 1)
    return a.reshape((a.shape[0], a.shape[1] * a.shape[2]) + a.shape[3:])


def causal_mask(q_idx, k_idx, k_valid):
    return (k_idx[None, :] <= q_idx[:, None]) & k_valid[None, :]


def diff_attention(q, k, v, lam, k_valid):
    L = q.shape[1]
    idx = jnp.arange(L)
    scale = DIFF_HEAD_DIM ** -0.5

    def block(args):
        qb, qi = args
        s = jnp.einsum('bqhcd,bkhcd->bhcqk', qb, k).astype(jnp.float32) * scale
        m = causal_mask(qi, idx, k_valid)
        p = jax.nn.softmax(jnp.where(m, s, NEG_INF), axis=-1)
        w = p[:, :, 0] - lam * p[:, :, 1]
        return jnp.einsum('bhqk,bkhe->bqhe', w.astype(v.dtype), v)

    return from_blocks(lax.map(block, (to_blocks(q), idx.reshape(-1, BLOCK))))


def mla_attention(qn, qr, kn, kr, v, k_valid):
    L = qn.shape[1]
    idx = jnp.arange(L)
    scale = (MLA_NOPE + MLA_ROPE) ** -0.5

    def block(args):
        qnb, qrb, qi = args
        s = (jnp.einsum('bqhd,bkhd->bhqk', qnb, kn)
             + jnp.einsum('bqhr,bkr->bhqk', qrb, kr)).astype(jnp.float32) * scale
        m = causal_mask(qi, idx, k_valid)
        p = jax.nn.softmax(jnp.where(m, s, NEG_INF), axis=-1)
        return jnp.einsum('bhqk,bkhe->bqhe', p.astype(v.dtype), v)

    return from_blocks(lax.map(block, (to_blocks(qn), to_blocks(qr), idx.reshape(-1, BLOCK))))


def swa_sink_attention(q, k, v, sinks, k_valid):
    L = q.shape[1]
    scale = SWA_HEAD_DIM ** -0.5
    kp = jnp.pad(k, ((0, 0), (BLOCK, 0), (0, 0), (0, 0)))
    vp = jnp.pad(v, ((0, 0), (BLOCK, 0), (0, 0), (0, 0)))
    validp = jnp.pad(k_valid, (BLOCK, 0))
    meta_k = k[:, N_FRONT:BLOCK]
    meta_v = v[:, N_FRONT:BLOCK]
    sink = sinks.reshape(SWA_KV_HEADS, SWA_GROUP)[None, :, :, None, None].astype(jnp.float32)
    band_off = jnp.arange(2 * BLOCK)
    q_off = jnp.arange(BLOCK)

    def block(args):
        qb, n = args
        start = n * BLOCK
        kb = lax.dynamic_slice_in_dim(kp, start, 2 * BLOCK, axis=1)
        vb = lax.dynamic_slice_in_dim(vp, start, 2 * BLOCK, axis=1)
        kvalid = lax.dynamic_slice_in_dim(validp, start, 2 * BLOCK, axis=0)
        q_idx = start + q_off
        k_idx = start - BLOCK + band_off
        keys = jnp.concatenate([meta_k, kb], axis=1)
        vals = jnp.concatenate([meta_v, vb], axis=1)
        s = jnp.einsum('bqhgd,bkhd->bhgqk', qb, keys).astype(jnp.float32) * scale
        dist = q_idx[:, None] - k_idx[None, :]
        is_meta = (k_idx >= N_FRONT) & (k_idx < BLOCK)
        band = kvalid[None, :] & (dist >= 0) & ((dist < WINDOW) | is_meta[None, :])
        extra = jnp.broadcast_to(n >= 2, (BLOCK, N_META))
        mask = jnp.concatenate([extra, band], axis=-1)
        s = jnp.where(mask, s, NEG_INF)
        m = jnp.maximum(jnp.max(s, axis=-1, keepdims=True), sink)
        e = jnp.exp(s - m)
        p = e / (jnp.sum(e, axis=-1, keepdims=True) + jnp.exp(sink - m))
        return jnp.einsum('bhgqk,bkhe->bqhge', p.astype(vals.dtype), vals)

    return from_blocks(lax.map(block, (to_blocks(q), jnp.arange(L // BLOCK))))


def ab_mixer(h, w_in, lq1, lk1, lq2, lk2, subln, q_norm, w_uq, kv_norm, w_ukv, w_out,
             lambda_init, cos_p, sin_p, cos_m, sin_m, k_valid):
    B, L, _ = h.shape
    proj = h @ w_in
    q_a, k_a, v_a, c_q, c_kv, k_r = jnp.split(proj, list(AB_SPLITS), axis=-1)
    q_a = partial_rope(q_a.reshape(B, L, DIFF_HEADS, 2, DIFF_HEAD_DIM), cos_p[:, None, None, :], sin_p[:, None, None, :])
    k_a = partial_rope(k_a.reshape(B, L, DIFF_HEADS, 2, DIFF_HEAD_DIM), cos_p[:, None, None, :], sin_p[:, None, None, :])
    v_a = v_a.reshape(B, L, DIFF_HEADS, DIFF_V_DIM)
    lam = (jnp.exp(jnp.sum(lq1.astype(jnp.float32) * lk1.astype(jnp.float32)))
           - jnp.exp(jnp.sum(lq2.astype(jnp.float32) * lk2.astype(jnp.float32))) + lambda_init)
    o_a = diff_attention(q_a, k_a, v_a, lam, k_valid)
    o_a = (rms_norm(o_a, subln, DIFF_EPS) * (1.0 - lambda_init)).reshape(B, L, DIFF_V_COLS)
    q_b = (rms_norm(c_q, q_norm) @ w_uq).reshape(B, L, MLA_HEADS, MLA_NOPE + MLA_ROPE)
    qn = q_b[..., :MLA_NOPE]
    qr = apply_rope(q_b[..., MLA_NOPE:], cos_m[:, None, :], sin_m[:, None, :])
    kv = (rms_norm(c_kv, kv_norm) @ w_ukv).reshape(B, L, MLA_HEADS, MLA_NOPE + MLA_V)
    kn = kv[..., :MLA_NOPE]
    v_b = kv[..., MLA_NOPE:]
    kr = apply_rope(k_r, cos_m, sin_m)
    o_b = mla_attention(qn, qr, kn, kr, v_b, k_valid).reshape(B, L, MLA_HEADS * MLA_V)
    return jnp.concatenate([o_a, o_b], axis=-1) @ w_out


def swa_mixer(h, w_qkv, b_qkv, sinks, w_out, b_out, cos_p, sin_p, k_valid):
    B, L, _ = h.shape
    proj = h @ w_qkv + b_qkv
    q, k, v = jnp.split(proj, [SWA_Q_COLS, SWA_Q_COLS + SWA_KV_COLS], axis=-1)
    q = partial_rope(q.reshape(B, L, SWA_HEADS, SWA_HEAD_DIM), cos_p[:, None, :], sin_p[:, None, :])
    k = partial_rope(k.reshape(B, L, SWA_KV_HEADS, SWA_HEAD_DIM), cos_p[:, None, :], sin_p[:, None, :])
    v = v.reshape(B, L, SWA_KV_HEADS, SWA_HEAD_DIM)
    q = q.reshape(B, L, SWA_KV_HEADS, SWA_GROUP, SWA_HEAD_DIM)
    o = swa_sink_attention(q, k, v, sinks, k_valid).reshape(B, L, SWA_Q_COLS)
    return o @ w_out + b_out


def setup_inputs(seed: int = 0) -> dict:
    key = jax.random.key(seed)
    ks = iter(jax.random.split(key, 40))

    def nrm(shape, scale):
        return jax.random.normal(next(ks), shape, jnp.float32) * scale

    def gain(shape):
        return 1.0 + nrm(shape, 0.02)

    D, F = D_MODEL, D_FF
    return {
        "x": nrm((BATCH, SEQ, D), 1.0),
        "meta_tokens": nrm((N_META, D), 1.0),
        "ffn1_norm": gain((DEPTH, D)),
        "ffn1_w_gate": nrm((DEPTH, D, F), D ** -0.5),
        "ffn1_w_up": nrm((DEPTH, D, F), D ** -0.5),
        "ffn1_w_down": nrm((DEPTH, F, D), F ** -0.5),
        "mix_norm": gain((DEPTH, D)),
        "ab_w_in": nrm((N_EVEN, D, AB_IN_COLS), D ** -0.5),
        "diff_lambda_q1": nrm((N_EVEN, DIFF_HEAD_DIM), 0.1),
        "diff_lambda_k1": nrm((N_EVEN, DIFF_HEAD_DIM), 0.1),
        "diff_lambda_q2": nrm((N_EVEN, DIFF_HEAD_DIM), 0.1),
        "diff_lambda_k2": nrm((N_EVEN, DIFF_HEAD_DIM), 0.1),
        "diff_subln": gain((N_EVEN, DIFF_V_DIM)),
        "mla_q_norm": gain((N_EVEN, MLA_Q_RANK)),
        "mla_w_uq": nrm((N_EVEN, MLA_Q_RANK, MLA_HEADS * (MLA_NOPE + MLA_ROPE)), MLA_Q_RANK ** -0.5),
        "mla_kv_norm": gain((N_EVEN, MLA_KV_RANK)),
        "mla_w_ukv": nrm((N_EVEN, MLA_KV_RANK, MLA_HEADS * (MLA_NOPE + MLA_V)), MLA_KV_RANK ** -0.5),
        "ab_w_out": nrm((N_EVEN, AB_OUT_COLS, D), AB_OUT_COLS ** -0.5),
        "swa_w_qkv": nrm((N_ODD, D, SWA_IN_COLS), D ** -0.5),
        "swa_b_qkv": nrm((N_ODD, SWA_IN_COLS), 0.02),
        "swa_sinks": nrm((N_ODD, SWA_HEADS), 0.5),
        "swa_w_out": nrm((N_ODD, SWA_Q_COLS, D), SWA_Q_COLS ** -0.5),
        "swa_b_out": nrm((N_ODD, D), 0.02),
        "ffn2_norm": gain((DEPTH, D)),
        "ffn2_w_gate": nrm((DEPTH, D, F), D ** -0.5),
        "ffn2_w_up": nrm((DEPTH, D, F), D ** -0.5),
        "ffn2_w_down": nrm((DEPTH, F, D), F ** -0.5),
        "final_norm": gain((D,)),
    }


def reference(x, meta_tokens, ffn1_norm, ffn1_w_gate, ffn1_w_up, ffn1_w_down, mix_norm,
              ab_w_in, diff_lambda_q1, diff_lambda_k1, diff_lambda_q2, diff_lambda_k2, diff_subln,
              mla_q_norm, mla_w_uq, mla_kv_norm, mla_w_ukv, ab_w_out,
              swa_w_qkv, swa_b_qkv, swa_sinks, swa_w_out, swa_b_out,
              ffn2_norm, ffn2_w_gate, ffn2_w_up, ffn2_w_down, final_norm):
    B = x.shape[0]
    meta = jnp.broadcast_to(meta_tokens[None].astype(x.dtype), (B, N_META, D_MODEL))
    h = jnp.concatenate([jnp.zeros((B, N_FRONT, D_MODEL), x.dtype), meta, x], axis=1)
    L = h.shape[1]
    idx = jnp.arange(L)
    k_valid = idx >= N_FRONT
    pos = jnp.maximum(idx - N_FRONT, 0)
    cos_p, sin_p = rope_tables(pos, DIFF_HEAD_DIM // ROT_FRAC_DIV)
    cos_m, sin_m = rope_tables(pos, MLA_ROPE)
    for l in range(DEPTH):
        h = h + 0.5 * swiglu(rms_norm(h, ffn1_norm[l]), ffn1_w_gate[l], ffn1_w_up[l], ffn1_w_down[l])
        hn = rms_norm(h, mix_norm[l])
        if l % 2 == 0:
            e = l // 2
            lambda_init = 0.8 - 0.6 * math.exp(-0.3 * l)
            h = h + ab_mixer(hn, ab_w_in[e], diff_lambda_q1[e], diff_lambda_k1[e], diff_lambda_q2[e],
                             diff_lambda_k2[e], diff_subln[e], mla_q_norm[e], mla_w_uq[e],
                             mla_kv_norm[e], mla_w_ukv[e], ab_w_out[e], lambda_init,
                             cos_p, sin_p, cos_m, sin_m, k_valid)
        else:
            o = l // 2
            h = h + swa_mixer(hn, swa_w_qkv[o], swa_b_qkv[o], swa_sinks[o], swa_w_out[o], swa_b_out[o],
                              cos_p, sin_p, k_valid)
        h = h + 0.5 * swiglu(rms_norm(h, ffn2_norm[l]), ffn2_w_gate[l], ffn2_w_up[l], ffn2_w_down[l])
    h = rms_norm(h, final_norm)
    return h[:, BLOCK:]
```

```cpp
#include <hip/hip_runtime.h>
#include <hip/hip_cooperative_groups.h>
#include <cstdio>
#include <cstdint>
#include <cmath>
namespace cg = cooperative_groups;
#ifndef MK_PER_PHASE
#define MK_PER_PHASE 0
#endif
#ifndef PROBE_MASK
#define PROBE_MASK 0u
#endif
#ifndef PROBE_N
#define PROBE_N 2
#endif
namespace pg8 {
#define PG8_LAS __attribute__((address_space(3)))
typedef unsigned short bf16_t;
typedef short bf16x8 __attribute__((ext_vector_type(8)));
typedef float f32x4 __attribute__((ext_vector_type(4)));
typedef unsigned u32x4 __attribute__((ext_vector_type(4)));
constexpr int BM = 256, BK = 64, HALF = 128, HTB = HALF * BK * 2  , STAGE_BYTES = 8 * HTB, NXCD = 8, WGM = 8;

__host__ __device__ __forceinline__ int lds_byte(int r, int c) { const int st = (r >> 4) * 2 + (c >> 5), rr = r & 15, cc = c & 31, ob = rr * 64 + cc * 2; return st * 1024 + (ob ^ (((ob >> 9) & 1) << 5)); }
__host__ __device__ __forceinline__ void stage_rc(int b, int& R, int& C) { const int st = b / 1024, sb = b % 1024, swz = sb ^ (((sb >> 9) & 1) << 5); R = (st >> 1) * 16 + swz / 64; C = (st & 1) * 32 + (swz % 64) / 2; }
__host__ __device__ __forceinline__ int perm32(int rho) { const int n = rho >> 4, i = rho & 15; return 8 * (i >> 2) + 4 * n + (i & 3); }

struct Unit { int pm, pn; };
struct Gemm { const bf16_t* A; const bf16_t* Bt; int M, N, K; };

struct StaticOrder {
    int nM, nN, nwg, G, c;
    __host__ __device__ void init(int M, int N, int G_, int c_) { nM = M / BM; nN = N / BM; nwg = nM * nN; G = G_; c = c_; }
    __host__ __device__ bool next(int i, Unit& u) const {
        const long L = (long)i * G + c; if (L >= nwg) return false;
        int wgid = (int)L; { const int q = nwg / NXCD, r = nwg % NXCD, xcd = wgid % NXCD, off = wgid / NXCD; wgid = (xcd < r ? xcd * (q + 1) : r * (q + 1) + (xcd - r) * q) + off; }
        const int nig = WGM * nN, gid = wgid / nig, fm = gid * WGM, gsz = (nM - fm) < WGM ? (nM - fm) : WGM;
        u.pm = fm + ((wgid % nig) % gsz); u.pn = (wgid % nig) / gsz; return true;
    }
    __device__ __forceinline__ void a_ready(const Unit&) const {}
    __device__ __forceinline__ void done(const Unit&) const {}
};

__device__ __forceinline__ unsigned cvt_pk_bf16(float lo, float hi) { unsigned r; asm volatile("v_cvt_pk_bf16_f32 %0, %1, %2" : "=v"(r) : "v"(lo), "v"(hi)); return r; }
template <class Epi, class Sched, bool ALIGN_EPI = false, bool SP2 = false>
__device__ __forceinline__ void gemm_phase(PG8_LAS unsigned char* lds, const Gemm g, const Sched& S, const Epi& E) {
    int tid_l = threadIdx.x; asm volatile("" : "+v"(tid_l)); const int tid = tid_l, wid = __builtin_amdgcn_readfirstlane(tid >> 6), lane = tid & 63, wr = wid >> 2, wc = wid & 3, fr = lane & 15, fq = lane >> 4;
    const int K = g.K, nt = K / BK;
    unsigned voffA[2], voffB[2];
#pragma unroll
    for (int i = 0; i < 2; ++i) { int R, C; stage_rc(tid * 16 + i * 8192, R, C); const int Rb = Epi::PERM ? ((R & ~31) + perm32(R & 31)) : R;
        voffA[i] = (unsigned)(R * K + C) * 2u; voffB[i] = (unsigned)(Rb * K + C) * 2u; }
    const size_t kstep = (size_t)(BK * 2);
    const size_t hstep = (size_t)HALF * K * 2;
    const size_t tstep = 2 * hstep;
    const unsigned ldsw = (unsigned)wid * 1024u;
    const int aoff = lds_byte(wr * 64 + fr, fq * 8), boff = lds_byte(wc * 32 + fr, fq * 8);
#define PG8_SA(b, h) (((b) * 2 + (h)) * HTB)
#define PG8_SB(b, h) ((4 + (b) * 2 + (h)) * HTB)
#define PG8_STAGE(bufoff, gbase, voff) do { _Pragma("unroll") for (int _i = 0; _i < 2; ++_i) \
        __builtin_amdgcn_global_load_lds((const unsigned*)((const char*)(gbase) + (voff)[_i]), (PG8_LAS unsigned*)(lds + (bufoff) + ldsw + _i * 8192), 16, 0, 0); } while (0)
#define PG8_LDA(dst, b, h) do { _Pragma("unroll") for (int m = 0; m < 4; ++m) _Pragma("unroll") for (int k = 0; k < 2; ++k) dst[m][k] = *(const PG8_LAS bf16x8*)(lds + PG8_SA(b, h) + aoff + m * 2048 + k * 1024); } while (0)
#define PG8_LDB(dst, b, h) do { _Pragma("unroll") for (int n = 0; n < 2; ++n) _Pragma("unroll") for (int k = 0; k < 2; ++k) dst[n][k] = *(const PG8_LAS bf16x8*)(lds + PG8_SB(b, h) + boff + n * 2048 + k * 1024); } while (0)
#define PG8_MMA(ai, bj, At, Bt) do { __builtin_amdgcn_s_setprio(1); _Pragma("unroll") for (int m = 0; m < 4; ++m) _Pragma("unroll") for (int n = 0; n < 2; ++n) _Pragma("unroll") for (int k = 0; k < 2; ++k) \
        acc[ai][bj][m][n] = __builtin_amdgcn_mfma_f32_16x16x32_bf16(Bt[n][k], At[m][k], acc[ai][bj][m][n], 0, 0, 0); __builtin_amdgcn_s_setprio(0); } while (0)
#define PG8_WAIT_V(n) asm volatile("s_waitcnt vmcnt(" #n ")" ::: "memory")
#define PG8_WAIT_L(n) asm volatile("s_waitcnt lgkmcnt(" #n ")" ::: "memory")
#define PG8_BAR __builtin_amdgcn_s_barrier()
#define PG8_SCHED __builtin_amdgcn_sched_barrier(0)
    Unit cur, nxt; int ui = 0;
    if (!S.next(0, cur)) return;
    f32x4 acc[2][2][4][2];
#pragma unroll
    for (int a = 0; a < 2; ++a)
#pragma unroll
        for (int b = 0; b < 2; ++b)
#pragma unroll
            for (int m = 0; m < 4; ++m)
#pragma unroll
                for (int n = 0; n < 2; ++n) acc[a][b][m][n] = (f32x4){0.f, 0.f, 0.f, 0.f};
    bf16x8 At[4][2], B0[2][2], B1[2][2];
    const char* cA = (const char*)g.A + (size_t)cur.pm * tstep; const char* cB = (const char*)g.Bt + (size_t)cur.pn * tstep;
    S.a_ready(cur);
    if constexpr (SP2) {
        PG8_STAGE(PG8_SB(0, 0), cB, voffB); PG8_STAGE(PG8_SB(0, 1), cB + hstep, voffB); PG8_STAGE(PG8_SA(0, 0), cA, voffA); PG8_STAGE(PG8_SA(0, 1), cA + hstep, voffA);
        if (wr == 1) PG8_BAR;
        PG8_WAIT_V(2); PG8_BAR;
        PG8_STAGE(PG8_SB(1, 0), cB + kstep, voffB); PG8_STAGE(PG8_SA(1, 0), cA + kstep, voffA); PG8_STAGE(PG8_SB(1, 1), cB + hstep + kstep, voffB);
        PG8_WAIT_V(6); PG8_BAR;
    } else {
        PG8_STAGE(PG8_SB(0, 0), cB, voffB); PG8_STAGE(PG8_SA(0, 0), cA, voffA); PG8_STAGE(PG8_SB(0, 1), cB + hstep, voffB); PG8_STAGE(PG8_SA(0, 1), cA + hstep, voffA);
        if (wr == 1) PG8_BAR;
        PG8_WAIT_V(4); PG8_BAR;
        PG8_STAGE(PG8_SB(1, 0), cB + kstep, voffB); PG8_STAGE(PG8_SA(1, 0), cA + kstep, voffA); PG8_STAGE(PG8_SB(1, 1), cB + hstep + kstep, voffB);
        PG8_WAIT_V(6); PG8_BAR;
    }
    for (;;) {
        const bool has_next = S.next(ui + 1, nxt);
        const char* nA = has_next ? (const char*)g.A + (size_t)nxt.pm * tstep : cA; const char* nB = has_next ? (const char*)g.Bt + (size_t)nxt.pn * tstep : cB;
        for (int t = 0; t < nt; t += 2) {
            const bool last = (t == nt - 2);
            const char* a1 = cA + (size_t)(t + 1) * kstep;
            const char* a2 = last ? nA : cA + (size_t)(t + 2) * kstep; const char* b2 = last ? nB : cB + (size_t)(t + 2) * kstep;
            const char* a3 = a2 + kstep; const char* b3 = b2 + kstep;
            if (last && has_next) S.a_ready(nxt);
            if constexpr (SP2) {
            PG8_LDB(B0, 0, 0); PG8_LDB(B1, 0, 1); PG8_SCHED; PG8_LDA(At, 0, 0); PG8_STAGE(PG8_SA(1, 1), a1 + hstep, voffA);
            PG8_WAIT_V(8); PG8_WAIT_L(0); PG8_BAR; PG8_MMA(0, 0, At, B0); PG8_MMA(0, 1, At, B1); PG8_BAR; PG8_SCHED;
            PG8_LDA(At, 0, 1); PG8_STAGE(PG8_SB(0, 0), b2, voffB); PG8_STAGE(PG8_SB(0, 1), b2 + hstep, voffB); PG8_STAGE(PG8_SA(0, 0), a2, voffA);
            PG8_WAIT_V(8); PG8_WAIT_L(0); PG8_BAR; PG8_MMA(1, 0, At, B0); PG8_MMA(1, 1, At, B1); PG8_BAR; PG8_SCHED;
            PG8_LDB(B0, 1, 0); PG8_LDB(B1, 1, 1); PG8_SCHED; PG8_LDA(At, 1, 0); PG8_STAGE(PG8_SA(0, 1), a2 + hstep, voffA);
            PG8_WAIT_V(8); PG8_WAIT_L(0); PG8_BAR; PG8_MMA(0, 0, At, B0); PG8_MMA(0, 1, At, B1); PG8_BAR; PG8_SCHED;
            PG8_LDA(At, 1, 1); PG8_STAGE(PG8_SB(1, 0), b3, voffB); PG8_STAGE(PG8_SB(1, 1), b3 + hstep, voffB); PG8_STAGE(PG8_SA(1, 0), a3, voffA);
            PG8_WAIT_V(8); PG8_WAIT_L(0); PG8_BAR; PG8_MMA(1, 0, At, B0); PG8_MMA(1, 1, At, B1); PG8_BAR; PG8_SCHED;
            } else {
            PG8_LDB(B0, 0, 0); PG8_SCHED; PG8_LDA(At, 0, 0); PG8_STAGE(PG8_SA(1, 1), a1 + hstep, voffA);
            PG8_WAIT_L(8); PG8_BAR; PG8_WAIT_L(0); PG8_MMA(0, 0, At, B0); PG8_BAR; PG8_SCHED;
            PG8_LDB(B1, 0, 1); PG8_STAGE(PG8_SB(0, 0), b2, voffB);
            PG8_BAR; PG8_WAIT_L(0); PG8_MMA(0, 1, At, B1); PG8_BAR;
            PG8_LDA(At, 0, 1); PG8_STAGE(PG8_SA(0, 0), a2, voffA);
            PG8_BAR; PG8_WAIT_L(0); PG8_MMA(1, 0, At, B0); PG8_BAR; PG8_SCHED;
            PG8_STAGE(PG8_SB(0, 1), b2 + hstep, voffB);
            PG8_WAIT_V(6); PG8_BAR; PG8_MMA(1, 1, At, B1); PG8_BAR;
            PG8_LDB(B0, 1, 0); PG8_SCHED; PG8_LDA(At, 1, 0); PG8_STAGE(PG8_SA(0, 1), a2 + hstep, voffA);
            PG8_WAIT_L(8); PG8_BAR; PG8_WAIT_L(0); PG8_MMA(0, 0, At, B0); PG8_BAR; PG8_SCHED;
            PG8_LDB(B1, 1, 1); PG8_STAGE(PG8_SB(1, 0), b3, voffB);
            PG8_BAR; PG8_WAIT_L(0); PG8_MMA(0, 1, At, B1); PG8_BAR;
            PG8_LDA(At, 1, 1); PG8_STAGE(PG8_SA(1, 0), a3, voffA);
            PG8_BAR; PG8_WAIT_L(0); PG8_MMA(1, 0, At, B0); PG8_BAR; PG8_SCHED;
            PG8_STAGE(PG8_SB(1, 1), b3 + hstep, voffB);
            PG8_WAIT_V(6); PG8_BAR; PG8_MMA(1, 1, At, B1); PG8_BAR;
            }
        }
        if constexpr (ALIGN_EPI) { if (wr == 0) PG8_BAR; }
        if constexpr (!Epi::AFTER_DRAIN) { E(acc, cur, wr, wc, fr, fq); S.done(cur); }
        if (!has_next) break;
#pragma unroll
        for (int a = 0; a < 2; ++a)
#pragma unroll
            for (int b = 0; b < 2; ++b)
#pragma unroll
                for (int m = 0; m < 4; ++m)
#pragma unroll
                    for (int n = 0; n < 2; ++n) acc[a][b][m][n] = (f32x4){0.f, 0.f, 0.f, 0.f};
        cur = nxt; cA = nA; cB = nB; ++ui;
        if constexpr (ALIGN_EPI) { if (wr == 1) PG8_BAR; }
    }
    PG8_WAIT_V(0);
    if constexpr (!ALIGN_EPI) { if (wr == 0) PG8_BAR; }
    PG8_BAR;
    if constexpr (Epi::AFTER_DRAIN) { E.fused(acc, cur, wr, wc, fr, fq, lds, wid, lane); S.done(cur); }
#undef PG8_SA
#undef PG8_SB
#undef PG8_STAGE
#undef PG8_LDA
#undef PG8_LDB
#undef PG8_MMA
#undef PG8_WAIT_V
#undef PG8_WAIT_L
#undef PG8_BAR
#undef PG8_SCHED
}
}
#define LAS __attribute__((address_space(3)))
#define DI __device__ __forceinline__
typedef unsigned short bf16_t;
typedef short bf16x8 __attribute__((ext_vector_type(8)));
typedef short s16x4 __attribute__((ext_vector_type(4)));
typedef float f32x4 __attribute__((ext_vector_type(4)));
typedef float f32x16 __attribute__((ext_vector_type(16)));
typedef unsigned u32x4 __attribute__((ext_vector_type(4)));
typedef unsigned u32x2 __attribute__((ext_vector_type(2)));
typedef float f32x2_t __attribute__((ext_vector_type(2)));
typedef __bf16 bf16x2_t __attribute__((ext_vector_type(2)));

constexpr int NB = 4, SEQ = 8192, LROW = 8320, R = NB * LROW, D = 1024, FF = 2816, NFRONT = 112, NPOS = 8208;
constexpr int NWIN = 2304, NUQ = 768, NUKV = 1024, NQKV = 1280;
constexpr float LOG2E = 1.4426950408889634f;
constexpr float NEGBIG = -1e30f;
constexpr float EPS = 1e-6f;

constexpr size_t MiB = 1u << 20;
constexpr size_t WS_CTL = 0;
constexpr size_t WS_SSQ = 1 * MiB;
constexpr size_t WS_TABP = 3 * MiB;
constexpr size_t WS_TABM = WS_TABP + 768 * 1024;
constexpr size_t WS_W = 6 * MiB;
constexpr size_t W_GU = (size_t)5632 * 1024, W_DN = (size_t)1024 * 2816;
constexpr size_t WOFF_FFN = 0;
constexpr size_t WOFF_WIN = 4 * (W_GU + W_DN);
constexpr size_t WOFF_UQ = WOFF_WIN + (size_t)NWIN * 1024;
constexpr size_t WOFF_UKV = WOFF_UQ + (size_t)NUQ * 256;
constexpr size_t WOFF_WO0 = WOFF_UKV + (size_t)NUKV * 256;
constexpr size_t WOFF_QKV = WOFF_WO0 + (size_t)1024 * 1024;
constexpr size_t WOFF_WO1 = WOFF_QKV + (size_t)NQKV * 1024;
constexpr size_t W_TOTAL = WOFF_WO1 + (size_t)1024 * 1024;
constexpr size_t WS_BQKV = WS_W + 80 * MiB;
static_assert(W_TOTAL * 2 <= 79 * MiB, "weights fit");
constexpr size_t WS_H = 87 * MiB;
constexpr size_t WS_HB = WS_H + (size_t)R * D * 4;
constexpr size_t WS_ACT = WS_HB + (size_t)R * D * 2;
constexpr size_t SZ512 = (size_t)R * 512 * 2, SZ768 = (size_t)R * 768 * 2, SZ256 = (size_t)R * 256 * 2;
constexpr size_t WS_QA = WS_ACT, WS_KA = WS_QA + SZ512, WS_VA = WS_KA + SZ512, WS_QM = WS_VA + SZ512, WS_CQ = WS_QM + SZ768, WS_CKV = WS_CQ + SZ256;
static_assert(WS_CKV + SZ256 <= WS_ACT + (size_t)R * FF * 2, "layer-0 attention inputs overlay act");
constexpr size_t WS_KM = WS_ACT + (size_t)R * FF * 2;
constexpr size_t WS_END = WS_KM + SZ768;
static_assert(WS_END <= 512 * MiB, "d_ws map fits 512 MiB");
constexpr size_t WS_QS = WS_ACT, WS_KS = WS_QS + (size_t)R * 1024 * 2, WS_VS = WS_KS + (size_t)R * 128 * 2, WS_OS = WS_VS + (size_t)R * 128 * 2;
static_assert(WS_OS + (size_t)R * 1024 * 2 <= WS_KM, "layer-1 attention buffers overlay act");
constexpr size_t OUT_OAB = 0, OUT_VM = (size_t)R * 1024 * 2;
static_assert(OUT_VM + SZ512 <= (size_t)NB * SEQ * D * 4, "d_out scratch");

constexpr int LDS_BYTES = 147456, LDS_MISC = 131072;

struct Args {
    const float* in[28]; float* out; unsigned char* ws; int ph_lo, ph_hi;
};

#define GAS __attribute__((address_space(1)))
typedef const GAS float* gcf;
DI gcf INP(int i) { asm volatile("" : "+s"(i)); return ((const gcf*)__builtin_amdgcn_kernarg_segment_ptr())[i]; }
DI unsigned pk_bf16(float lo, float hi) { f32x2_t v = {lo, hi}; bf16x2_t b = __builtin_convertvector(v, bf16x2_t); return __builtin_bit_cast(unsigned, b); }
DI float bf_lo(unsigned u) { return __uint_as_float(u << 16); }
DI float bf_hi(unsigned u) { return __uint_as_float(u & 0xffff0000u); }
DI int row_pos(int row) { const int i = row % LROW; return i > NFRONT ? i - NFRONT : 0; }
DI int permP(int d) { return d < 16 ? ((d & 1) ? (d >> 1) + 8 : (d >> 1)) : d; }
DI int permM(int d) { return (d & 1) ? (d >> 1) + 32 : (d >> 1); }
DI float wave_sum(float v) {
#pragma unroll
    for (int o = 1; o < 64; o <<= 1) v += __shfl_xor(v, o);
    return v;
}
DI void rope8(f32x4& v0, f32x4& v1, const float2* tab) {
    const float2 t0 = tab[0], t1 = tab[1], t2 = tab[2], t3 = tab[3];
    f32x4 a = v0, b = v1;
    v0[0] = a[0] * t0.x - a[1] * t0.y; v0[1] = a[1] * t0.x + a[0] * t0.y;
    v0[2] = a[2] * t1.x - a[3] * t1.y; v0[3] = a[3] * t1.x + a[2] * t1.y;
    v1[0] = b[0] * t2.x - b[1] * t2.y; v1[1] = b[1] * t2.x + b[0] * t2.y;
    v1[2] = b[2] * t3.x - b[3] * t3.y; v1[3] = b[3] * t3.x + b[2] * t3.y;
}
DI u32x4 pack8(const f32x4& a, const f32x4& b) { u32x4 w; w.x = pk_bf16(a[0], a[1]); w.y = pk_bf16(a[2], a[3]); w.z = pk_bf16(b[0], b[1]); w.w = pk_bf16(b[2], b[3]); return w; }

#define EPI_ROW(ai, m) (u.pm * 256 + (ai) * 128 + wr * 64 + (m) * 16 + fr)
typedef const f32x4 (&AccRef)[2][2][4][2];

struct EpiSwiglu {
    static constexpr bool PERM = true, AFTER_DRAIN = false;
    unsigned char* ws; int ssq_idx;
    DI void operator()(AccRef acc, const pg8::Unit& u, int wr, int wc, int fr, int fq) const {
        bf16_t* O = (bf16_t*)(ws + WS_ACT); const float* ssq = (const float*)(ws + WS_SSQ) + (size_t)ssq_idx * R;
        const int f0 = u.pn * 128 + wc * 32 + fq * 8;
#pragma unroll
        for (int ai = 0; ai < 2; ++ai)
#pragma unroll
            for (int m = 0; m < 4; ++m) {
                const int row = EPI_ROW(ai, m); asm volatile("" ::: "memory");
                const float rstd = rsqrtf(ssq[row] * (1.0f / D) + EPS);
                f32x4 o[2];
#pragma unroll
                for (int n = 0; n < 2; ++n) {
                    const f32x4 g = acc[ai][0][m][n] * rstd, up = acc[ai][1][m][n] * rstd;
#pragma unroll
                    for (int e = 0; e < 4; ++e) o[n][e] = g[e] * __builtin_amdgcn_rcpf(1.0f + __builtin_amdgcn_exp2f(-g[e] * LOG2E)) * up[e];
                }
                *(u32x4*)(O + (size_t)row * FF + f0) = pack8(o[0], o[1]);
            }
    }
};

struct EpiResid {
    static constexpr bool PERM = true, AFTER_DRAIN = false;
    unsigned char* ws; int ssq_idx; int has_bias; float alpha;
    DI void operator()(AccRef acc, const pg8::Unit& u, int wr, int wc, int fr, int fq) const {
        float* h = (float*)(ws + WS_H); bf16_t* hb = (bf16_t*)(ws + WS_HB); float* ssq_out = (float*)(ws + WS_SSQ) + (size_t)ssq_idx * R; gcf bias = has_bias ? INP(22) : nullptr;
#pragma unroll
        for (int ai = 0; ai < 2; ++ai)
#pragma unroll
            for (int m = 0; m < 4; ++m) {
                const int row = EPI_ROW(ai, m); if (m == 0) asm volatile("" ::: "memory");
                float ss = 0.f;
#pragma unroll
                for (int bj = 0; bj < 2; ++bj) {
                    const int c = u.pn * 256 + bj * 128 + wc * 32 + fq * 8;
                    float* hp = h + (size_t)row * D + c;
                    f32x4 h0 = __builtin_nontemporal_load((const f32x4*)hp), h1 = __builtin_nontemporal_load((const f32x4*)(hp + 4));
                    h0 += acc[ai][bj][m][0] * alpha; h1 += acc[ai][bj][m][1] * alpha;
                    if (bias) { h0 += *(const GAS f32x4*)(bias + c); h1 += *(const GAS f32x4*)(bias + c + 4); }
                    __builtin_nontemporal_store(h0, (f32x4*)hp); __builtin_nontemporal_store(h1, (f32x4*)(hp + 4));
                    *(u32x4*)(hb + (size_t)row * D + c) = pack8(h0, h1);
                    ss += (h0[0] * h0[0] + h0[1] * h0[1]) + (h0[2] * h0[2] + h0[3] * h0[3]) + (h1[0] * h1[0] + h1[1] * h1[1]) + (h1[2] * h1[2] + h1[3] * h1[3]);
                }
                ss += __shfl_xor(ss, 16); ss += __shfl_xor(ss, 32);
                if (fq == 0) atomicAdd(ssq_out + row, ss);
            }
    }
};

struct EpiWin {
    static constexpr bool PERM = true, AFTER_DRAIN = false;
    unsigned char* ws; float qscale;
    DI void operator()(AccRef acc, const pg8::Unit& u, int wr, int wc, int fr, int fq) const {
        const float* ssq = (const float*)(ws + WS_SSQ) + (size_t)1 * R; float* ssq_cq = (float*)(ws + WS_SSQ) + (size_t)7 * R; float* ssq_ckv = (float*)(ws + WS_SSQ) + (size_t)8 * R;
        bf16_t *QA = (bf16_t*)(ws + WS_QA), *KA = (bf16_t*)(ws + WS_KA), *VA = (bf16_t*)(ws + WS_VA), *CQ = (bf16_t*)(ws + WS_CQ), *CKV = (bf16_t*)(ws + WS_CKV), *KM = (bf16_t*)(ws + WS_KM);
        const float2* tabP = (const float2*)(ws + WS_TABP); const float2* tabM = (const float2*)(ws + WS_TABM);
        const int pn = u.pn;
#pragma unroll
        for (int ai = 0; ai < 2; ++ai)
#pragma unroll
            for (int m = 0; m < 4; ++m) {
                const int row = EPI_ROW(ai, m); asm volatile("" ::: "memory");
                const int pos = row_pos(row);
                const float rstd = rsqrtf(ssq[row] * (1.0f / D) + EPS);
                float ss = 0.f;
#pragma unroll
                for (int bj = 0; bj < 2; ++bj) {
                    const int cl = bj * 128 + wc * 32 + fq * 8;
                    f32x4 v0 = acc[ai][bj][m][0] * rstd, v1 = acc[ai][bj][m][1] * rstd;
                    if (pn < 4) {
                        if ((cl & 63) < 16) rope8(v0, v1, tabP + pos * 8 + ((cl & 63) >> 1));
                        if (pn < 2) { v0 *= qscale; v1 *= qscale; }
                        bf16_t* dst = (pn < 2 ? QA : KA) + (size_t)row * 512 + (pn & 1) * 256 + cl;
                        *(u32x4*)dst = pack8(v0, v1);
                    } else if (pn < 6) {
                        *(u32x4*)(VA + (size_t)row * 512 + (pn - 4) * 256 + cl) = pack8(v0, v1);
                    } else if (pn < 8) {
                        *(u32x4*)((pn == 6 ? CQ : CKV) + (size_t)row * 256 + cl) = pack8(v0, v1);
                        ss += (v0[0] * v0[0] + v0[1] * v0[1]) + (v0[2] * v0[2] + v0[3] * v0[3]) + (v1[0] * v1[0] + v1[1] * v1[1]) + (v1[2] * v1[2] + v1[3] * v1[3]);
                    } else if (cl < 64) {
                        rope8(v0, v1, tabM + pos * 32 + (cl >> 1));
                        const u32x4 w = pack8(v0, v1);
#pragma unroll
                        for (int hh = 0; hh < 4; ++hh) *(u32x4*)(KM + (size_t)row * 768 + hh * 192 + 128 + cl) = w;
                    }
                }
                if (pn == 6 || pn == 7) {
                    ss += __shfl_xor(ss, 16); ss += __shfl_xor(ss, 32);
                    if (fq == 0) atomicAdd((pn == 6 ? ssq_cq : ssq_ckv) + row, ss);
                }
            }
    }
};

struct EpiUq {
    static constexpr bool PERM = true, AFTER_DRAIN = false;
    unsigned char* ws; float qscale;
    DI void operator()(AccRef acc, const pg8::Unit& u, int wr, int wc, int fr, int fq) const {
        const float* ssq_cq = (const float*)(ws + WS_SSQ) + (size_t)7 * R; bf16_t* QM = (bf16_t*)(ws + WS_QM); const float2* tabM = (const float2*)(ws + WS_TABM);
#pragma unroll
        for (int ai = 0; ai < 2; ++ai)
#pragma unroll
            for (int m = 0; m < 4; ++m) {
                const int row = EPI_ROW(ai, m); asm volatile("" ::: "memory");
                const int pos = row_pos(row);
                const float rstd = rsqrtf(ssq_cq[row] * (1.0f / 256) + EPS);
#pragma unroll
                for (int bj = 0; bj < 2; ++bj) {
                    const int c = u.pn * 256 + bj * 128 + wc * 32 + fq * 8;
                    const int d = c % 192;
                    f32x4 v0 = acc[ai][bj][m][0] * rstd, v1 = acc[ai][bj][m][1] * rstd;
                    if (d >= 128) rope8(v0, v1, tabM + pos * 32 + ((d - 128) >> 1));
                    v0 *= qscale; v1 *= qscale;
                    *(u32x4*)(QM + (size_t)row * 768 + c) = pack8(v0, v1);
                }
            }
    }
};

struct EpiUkv {
    static constexpr bool PERM = true, AFTER_DRAIN = false;
    unsigned char* ws; unsigned char* outb;
    DI void operator()(AccRef acc, const pg8::Unit& u, int wr, int wc, int fr, int fq) const {
        const float* ssq_ckv = (const float*)(ws + WS_SSQ) + (size_t)8 * R; bf16_t* KM = (bf16_t*)(ws + WS_KM); bf16_t* VM = (bf16_t*)(outb + OUT_VM);
#pragma unroll
        for (int ai = 0; ai < 2; ++ai)
#pragma unroll
            for (int m = 0; m < 4; ++m) {
                const int row = EPI_ROW(ai, m); asm volatile("" ::: "memory");
                const float rstd = rsqrtf(ssq_ckv[row] * (1.0f / 256) + EPS);
                const int cl = wc * 32 + fq * 8;
                *(u32x4*)(KM + (size_t)row * 768 + u.pn * 192 + cl) = pack8(acc[ai][0][m][0] * rstd, acc[ai][0][m][1] * rstd);
                *(u32x4*)(VM + (size_t)row * 512 + u.pn * 128 + cl) = pack8(acc[ai][1][m][0] * rstd, acc[ai][1][m][1] * rstd);
            }
    }
};

struct EpiQkvS {
    static constexpr bool PERM = true, AFTER_DRAIN = false;
    unsigned char* ws; float qscale;
    DI void operator()(AccRef acc, const pg8::Unit& u, int wr, int wc, int fr, int fq) const {
        const float* ssq = (const float*)(ws + WS_SSQ) + (size_t)4 * R; const float* bias = (const float*)(ws + WS_BQKV); bf16_t *QS = (bf16_t*)(ws + WS_QS), *KS = (bf16_t*)(ws + WS_KS), *VS = (bf16_t*)(ws + WS_VS); const float2* tabP = (const float2*)(ws + WS_TABP);
        const int pn = u.pn;
#pragma unroll
        for (int ai = 0; ai < 2; ++ai)
#pragma unroll
            for (int m = 0; m < 4; ++m) {
                const int row = EPI_ROW(ai, m); asm volatile("" ::: "memory");
                const int pos = row_pos(row);
                const float rstd = rsqrtf(ssq[row] * (1.0f / D) + EPS);
#pragma unroll
                for (int bj = 0; bj < 2; ++bj) {
                    const int cl = bj * 128 + wc * 32 + fq * 8, c = pn * 256 + cl;
                    f32x4 v0 = acc[ai][bj][m][0] * rstd + *(const f32x4*)(bias + c), v1 = acc[ai][bj][m][1] * rstd + *(const f32x4*)(bias + c + 4);
                    const bool isv = (pn == 4 && bj == 1);
                    if (!isv && (cl & 63) < 16) rope8(v0, v1, tabP + pos * 8 + ((cl & 63) >> 1));
                    if (pn < 4) { v0 *= qscale; v1 *= qscale; *(u32x4*)(QS + (size_t)row * 1024 + c) = pack8(v0, v1); }
                    else if (bj == 0) *(u32x4*)(KS + (size_t)row * 128 + cl) = pack8(v0, v1);
                    else *(u32x4*)(VS + (size_t)row * 128 + (cl - 128)) = pack8(v0, v1);
                }
            }
    }
};
#define MFMA32(a, b, c) __builtin_amdgcn_mfma_f32_32x32x16_bf16((a), (b), (c), 0, 0, 0)
typedef short v4i16_t __attribute__((ext_vector_type(4)));
DI s16x4 tr_read(const LAS unsigned char* p) { return __builtin_bit_cast(s16x4, __builtin_amdgcn_ds_read_tr16_b64_v4i16((LAS v4i16_t*)p)); }
DI float xhalf_max(float v) { auto rr = __builtin_amdgcn_permlane32_swap(__float_as_uint(v), __float_as_uint(v), false, false); return fmaxf(__uint_as_float(rr[0]), __uint_as_float(rr[1])); }
DI float xhalf_sum(float v) { auto rr = __builtin_amdgcn_permlane32_swap(__float_as_uint(v), __float_as_uint(v), false, false); return __uint_as_float(rr[0]) + __uint_as_float(rr[1]); }
DI float max3f(float a, float b, float c) { float r; asm("v_max3_f32 %0, %1, %2, %3" : "=v"(r) : "v"(a), "v"(b), "v"(c)); return r; }
DI int crow(int i, int h) { return (i & 3) + 8 * (i >> 2) + 4 * h; }

template <int DQK, int DV, int KP, int VP, bool MASKED, class MaskF>
DI void attn_tile(const LAS unsigned char* Ks, const LAS unsigned char* Vs, const bf16x8 (&qf)[DQK / 16], f32x16 (&o)[DV / 32], float& m, float& l, int lane, const MaskF& allowed) {
    const int r = lane & 31, h = lane >> 5;
    f32x16 s0, s1;
#pragma unroll
    for (int i = 0; i < 16; ++i) { s0[i] = 0.f; s1[i] = 0.f; }
    const LAS unsigned char* kb = Ks + r * KP + h * 16;
    __builtin_amdgcn_s_setprio(1);
#pragma unroll
    for (int ks = 0; ks < DQK / 16; ++ks) {
        if (ks == 6) asm volatile("" ::: "memory");
        const bf16x8 a0 = *(const LAS bf16x8*)(kb + ks * 32);
        const bf16x8 a1 = *(const LAS bf16x8*)(kb + 32 * KP + ks * 32);
        s0 = MFMA32(a0, qf[ks], s0); s1 = MFMA32(a1, qf[ks], s1);
    }
    __builtin_amdgcn_s_setprio(0);
    constexpr bool PFV = (DQK <= 64);
    const int q4 = (lane & 15) >> 2, p4 = lane & 3, blk = (lane >> 4) & 1;
    const LAS unsigned char* vb = Vs + (4 * h + q4) * VP + (16 * blk + 4 * p4) * 2;
    bf16x8 vcur[DV / 32];
    if (PFV) {
#pragma unroll
        for (int dt = 0; dt < DV / 32; ++dt) { const s16x4 lo = tr_read(vb + dt * 64), hi = tr_read(vb + 8 * VP + dt * 64); vcur[dt] = __builtin_shufflevector(lo, hi, 0, 1, 2, 3, 4, 5, 6, 7); }
    }
    asm volatile("" ::: "memory");
    if (MASKED) {
#pragma unroll
        for (int i = 0; i < 16; ++i) { const int k0 = crow(i, h); if (!allowed(k0)) s0[i] = NEGBIG; if (!allowed(32 + k0)) s1[i] = NEGBIG; }
    }
    float mxa = max3f(s0[0], s0[1], s1[0]), mxb = max3f(s0[2], s0[3], s1[1]);
    mxa = max3f(mxa, s1[2], s1[3]);
#pragma unroll
    for (int i = 4; i < 16; i += 4) { mxa = max3f(mxa, s0[i], s0[i + 1]); mxb = max3f(mxb, s0[i + 2], s0[i + 3]); mxa = max3f(mxa, s1[i], s1[i + 1]); mxb = max3f(mxb, s1[i + 2], s1[i + 3]); }
    const float mx = xhalf_max(fmaxf(mxa, mxb));
    const float mn = (mx > m + 8.0f) ? mx : m;
    if (__builtin_amdgcn_ballot_w64(mn != m) != 0ull) {
        const float alpha = __builtin_amdgcn_exp2f(m - mn);
        l *= alpha;
#pragma unroll
        for (int dt = 0; dt < DV / 32; ++dt) o[dt] *= alpha;
        m = mn;
    }
    float ps0 = 0.f, ps1 = 0.f;
#pragma unroll
    for (int i = 0; i < 16; ++i) { s0[i] = __builtin_amdgcn_exp2f(s0[i] - mn); s1[i] = __builtin_amdgcn_exp2f(s1[i] - mn); ps0 += s0[i]; ps1 += s1[i]; }
    l += ps0 + ps1;
    bf16x8 pb[4];
#pragma unroll
    for (int s = 0; s < 2; ++s) {
        u32x4 w0, w1;
        w0.x = pk_bf16(s0[8 * s + 0], s0[8 * s + 1]); w0.y = pk_bf16(s0[8 * s + 2], s0[8 * s + 3]); w0.z = pk_bf16(s0[8 * s + 4], s0[8 * s + 5]); w0.w = pk_bf16(s0[8 * s + 6], s0[8 * s + 7]);
        w1.x = pk_bf16(s1[8 * s + 0], s1[8 * s + 1]); w1.y = pk_bf16(s1[8 * s + 2], s1[8 * s + 3]); w1.z = pk_bf16(s1[8 * s + 4], s1[8 * s + 5]); w1.w = pk_bf16(s1[8 * s + 6], s1[8 * s + 7]);
        pb[s] = __builtin_bit_cast(bf16x8, w0); pb[2 + s] = __builtin_bit_cast(bf16x8, w1);
    }
    __builtin_amdgcn_s_setprio(1);
#pragma unroll
    for (int g = 0; g < 4; ++g) {
        bf16x8 vnext[DV / 32];
        if (PFV) {
            if (g < 3) {
#pragma unroll
                for (int dt = 0; dt < DV / 32; ++dt) { const s16x4 lo = tr_read(vb + (16 * (g + 1)) * VP + dt * 64), hi = tr_read(vb + (16 * (g + 1) + 8) * VP + dt * 64); vnext[dt] = __builtin_shufflevector(lo, hi, 0, 1, 2, 3, 4, 5, 6, 7); }
            }
            asm volatile("" ::: "memory");
        } else {
            asm volatile("" ::: "memory");
#pragma unroll
            for (int dt = 0; dt < DV / 32; ++dt) { const s16x4 lo = tr_read(vb + (16 * g) * VP + dt * 64), hi = tr_read(vb + (16 * g + 8) * VP + dt * 64); vcur[dt] = __builtin_shufflevector(lo, hi, 0, 1, 2, 3, 4, 5, 6, 7); }
        }
#pragma unroll
        for (int dt = 0; dt < DV / 32; ++dt) o[dt] = MFMA32(vcur[dt], pb[g], o[dt]);
        if (PFV && g < 3) {
#pragma unroll
            for (int dt = 0; dt < DV / 32; ++dt) vcur[dt] = vnext[dt];
        }
    }
    __builtin_amdgcn_s_setprio(0);
}

template <int NCH, int N>
DI void tile_load(u32x4 (&reg)[N], const bf16_t* src  , int pitch, int tid) {
#pragma unroll
    for (int i = 0; i < N; ++i) { const int c = tid + 512 * i, key = c / NCH, part = c % NCH; const unsigned off = (unsigned)(key * pitch + part * 8) * 2u;
        reg[i] = *(const u32x4*)((const unsigned char*)src + off); }
}
template <int NCH, int N, int PB>
DI void tile_store(const u32x4 (&reg)[N], LAS unsigned char* buf, int tid) {
#pragma unroll
    for (int i = 0; i < N; ++i) { const int c = tid + 512 * i, key = c / NCH, part = c % NCH; *(LAS u32x4*)(buf + key * PB + part * 16) = reg[i]; }
}

template <int DQK, int DV>
DI void causal_attn(LAS unsigned char* lds, const bf16_t* Qp, int qpitch, const bf16_t* Kp, int kpitch, const bf16_t* Vp, int vpitch, int q0, f32x16 (&o)[DV / 32], int tid) {
    constexpr int KP = DQK * 2 + 16, VP = DV * 2 + 64, KBUF = 64 * KP, VBUF = 64 * VP;
    constexpr int KCH = DQK / 8, VCH = DV / 8, KN = 64 * KCH / 512, VN = 64 * VCH / 512;
    LAS unsigned char* Kb = lds; LAS unsigned char* Vb = lds + 2 * KBUF;
    const int lane = tid & 63, w = tid >> 6, r = lane & 31, h = lane >> 5, qw = q0 + 32 * w;
    const int qtrue = qw + r, qrow = qtrue < 0 ? 0 : (qtrue > LROW - 1 ? LROW - 1 : qtrue);
    bf16x8 qf[DQK / 16];
#pragma unroll
    for (int ks = 0; ks < DQK / 16; ++ks) qf[ks] = *(const bf16x8*)(Qp + (size_t)qrow * qpitch + ks * 16 + h * 8);
    float m = NEGBIG, l = 0.f;
#pragma unroll
    for (int dt = 0; dt < DV / 32; ++dt)
#pragma unroll
        for (int i = 0; i < 16; ++i) o[dt][i] = 0.f;
    const int qlast = (q0 + 255 > LROW - 1) ? LROW - 1 : q0 + 255, ktend = qlast >> 6;
    const bool wactive = (qw + 31 >= NFRONT);
    u32x4 kreg[KN], vreg[VN];
    tile_load<KCH, KN>(kreg, Kp + (size_t)64 * kpitch, kpitch, tid); tile_load<VCH, VN>(vreg, Vp + (size_t)64 * vpitch, vpitch, tid);
    tile_store<KCH, KN, KP>(kreg, Kb, tid); tile_store<VCH, VN, VP>(vreg, Vb, tid);
    __syncthreads();
    int cur = 0;
    for (int kt = 1; kt <= ktend; ++kt) {
        if (kt < ktend) { tile_load<KCH, KN>(kreg, Kp + (size_t)(64 * (kt + 1)) * kpitch, kpitch, tid); tile_load<VCH, VN>(vreg, Vp + (size_t)(64 * (kt + 1)) * vpitch, vpitch, tid); }
        if (wactive && 64 * kt <= qw + 31) {
            const LAS unsigned char* Ks = Kb + cur * KBUF; const LAS unsigned char* Vs = Vb + cur * VBUF;
            const int k64 = 64 * kt;
            auto allowed = [&](int slot) { const int kg = k64 + slot; return kg <= qtrue && kg >= NFRONT; };
            if (k64 + 63 > qw || kt == 1) attn_tile<DQK, DV, KP, VP, true>(Ks, Vs, qf, o, m, l, lane, allowed);
            else attn_tile<DQK, DV, KP, VP, false>(Ks, Vs, qf, o, m, l, lane, allowed);
        }
        if (kt < ktend) { tile_store<KCH, KN, KP>(kreg, Kb + (cur ^ 1) * KBUF, tid); tile_store<VCH, VN, VP>(vreg, Vb + (cur ^ 1) * VBUF, tid); }
        __syncthreads();
        cur ^= 1;
    }
    l = xhalf_sum(l);
    const float inv = 1.0f / l;
#pragma unroll
    for (int dt = 0; dt < DV / 32; ++dt) o[dt] *= inv;
}

template <int NDT>
DI void store_oT(bf16_t* dst, const f32x16 (&o)[NDT], int h, bool zero) {
#pragma unroll
    for (int dt = 0; dt < NDT; ++dt)
#pragma unroll
        for (int g = 0; g < 4; ++g) {
            u32x2 w; w.x = pk_bf16(o[dt][4 * g], o[dt][4 * g + 1]); w.y = pk_bf16(o[dt][4 * g + 2], o[dt][4 * g + 3]);
            if (zero) { w.x = 0u; w.y = 0u; }
            *(u32x2*)(dst + 32 * dt + 8 * g + 4 * h) = w;
        }
}

struct AttnL0 { const bf16_t *QA, *KA, *VA, *QM, *KM, *VM; bf16_t* OAB; gcf subln; float lam; };

DI void attn_unit_diff(LAS unsigned char* lds, const AttnL0& A, int b, int hh, int t, int tid) {
    const int lane = tid & 63, w = tid >> 6, r = lane & 31, h = lane >> 5, q0 = 256 * t - 128, qtrue = q0 + 32 * w + r;
    const size_t rb = (size_t)b * LROW;
    const bf16_t* Vp = A.VA + rb * 512 + hh * 128;
    LAS unsigned* o1s = (LAS unsigned*)(lds + 61440) + tid;
    {
        f32x16 o1[4];
        causal_attn<64, 128>(lds, A.QA + rb * 512 + hh * 128 + 64, 512, A.KA + rb * 512 + hh * 128 + 64, 512, Vp, 512, q0, o1, tid);
#pragma unroll
        for (int dt = 0; dt < 4; ++dt)
#pragma unroll
            for (int i = 0; i < 8; ++i) o1s[(dt * 8 + i) * 512] = pk_bf16(o1[dt][2 * i], o1[dt][2 * i + 1]);
    }
    f32x16 o[4];
    causal_attn<64, 128>(lds, A.QA + rb * 512 + hh * 128, 512, A.KA + rb * 512 + hh * 128, 512, Vp, 512, q0, o, tid);
    float ss = 0.f;
#pragma unroll
    for (int dt = 0; dt < 4; ++dt)
#pragma unroll
        for (int i = 0; i < 8; ++i) {
            const unsigned pw = o1s[(dt * 8 + i) * 512];
            const float x0 = o[dt][2 * i] - A.lam * bf_lo(pw), x1 = o[dt][2 * i + 1] - A.lam * bf_hi(pw);
            o[dt][2 * i] = x0; o[dt][2 * i + 1] = x1; ss += x0 * x0 + x1 * x1;
        }
    ss = xhalf_sum(ss);
    const float rs = rsqrtf(ss * (1.0f / 128) + 1e-5f) * 0.8f;
#pragma unroll
    for (int dt = 0; dt < 4; ++dt)
#pragma unroll
        for (int g = 0; g < 4; ++g) { const f32x4 sg = *(const GAS f32x4*)(A.subln + 32 * dt + 8 * g + 4 * h);
#pragma unroll
            for (int e = 0; e < 4; ++e) o[dt][4 * g + e] *= rs * sg[e]; }
    if (qtrue >= 0 && qtrue < LROW) store_oT<4>(A.OAB + (rb + qtrue) * 1024 + hh * 128, o, h, qtrue < NFRONT);
}
DI void attn_unit_mla(LAS unsigned char* lds, const AttnL0& A, int b, int hh, int t, int tid) {
    const int lane = tid & 63, w = tid >> 6, r = lane & 31, h = lane >> 5, q0 = 256 * t - 128, qtrue = q0 + 32 * w + r;
    const size_t rb = (size_t)b * LROW;
    f32x16 o[4];
    causal_attn<192, 128>(lds, A.QM + rb * 768 + hh * 192, 768, A.KM + rb * 768 + hh * 192, 768, A.VM + rb * 512 + hh * 128, 512, q0, o, tid);
    if (qtrue >= 0 && qtrue < LROW) store_oT<4>(A.OAB + (rb + qtrue) * 1024 + 512 + hh * 128, o, h, qtrue < NFRONT);
}

struct AttnL1 { const bf16_t *QS, *KS, *VS; bf16_t* OS; gcf sinks; };
DI void attn_unit_swa(LAS unsigned char* lds, const AttnL1& A, int b, int kvh, int n, int tid) {
    constexpr int KP = 144, VP = 192, NROW = 320;
    LAS unsigned char* Kb = lds; LAS unsigned char* Vb = lds + NROW * KP;
    const size_t rb = (size_t)b * LROW;
    for (int c = tid; c < NROW * 8; c += 512) {
        const int j = c >> 3, part = c & 7;
        int gr = (j < 256) ? 128 * (n - 1) + j : ((j < 272) ? NFRONT + (j - 256) : -1);
        u32x4 kv = {0u, 0u, 0u, 0u}, vv = {0u, 0u, 0u, 0u};
        if (gr >= 0) { kv = *(const u32x4*)(A.KS + (rb + gr) * 128 + kvh * 64 + part * 8); vv = *(const u32x4*)(A.VS + (rb + gr) * 128 + kvh * 64 + part * 8); }
        *(LAS u32x4*)(Kb + j * KP + part * 16) = kv; *(LAS u32x4*)(Vb + j * VP + part * 16) = vv;
    }
    __syncthreads();
    const int lane = tid & 63, g = tid >> 6, r = lane & 31, h = lane >> 5, head = kvh * 8 + g;
    const float sink = A.sinks[head] * LOG2E;
    for (int j = 0; j < 4; ++j) {
        const int qtrue = 128 * n + 32 * j + r;
        bf16x8 qf[4];
#pragma unroll
        for (int ks = 0; ks < 4; ++ks) qf[ks] = *(const bf16x8*)(A.QS + (rb + qtrue) * 1024 + head * 64 + ks * 16 + h * 8);
        float m = sink, l = (h == 0) ? 1.0f : 0.0f;
        f32x16 o[2];
#pragma unroll
        for (int dt = 0; dt < 2; ++dt)
#pragma unroll
            for (int i = 0; i < 16; ++i) o[dt][i] = 0.f;
        const int tb0 = (j < 2) ? 0 : 1;
        for (int tb = tb0; tb < tb0 + 3; ++tb) {
            const int kbase = 128 * (n - 1) + 64 * tb;
            auto allowed = [&](int slot) { const int kg = kbase + slot; return kg <= qtrue && kg >= NFRONT && (kg < 128 || qtrue - kg < 128); };
            attn_tile<64, 64, KP, VP, true>(Kb + 64 * tb * KP, Vb + 64 * tb * VP, qf, o, m, l, lane, allowed);
        }
        if (n >= 2) {
            auto allowed = [&](int slot) { return slot < 16; };
            attn_tile<64, 64, KP, VP, true>(Kb + 256 * KP, Vb + 256 * VP, qf, o, m, l, lane, allowed);
        }
        l = xhalf_sum(l);
        const float inv = 1.0f / l;
#pragma unroll
        for (int dt = 0; dt < 2; ++dt) o[dt] *= inv;
        store_oT<2>(A.OS + (rb + qtrue) * 1024 + head * 64, o, h, qtrue < NFRONT);
    }
    __syncthreads();
}
DI int srccol(int kind, int nd) {
    if (kind == 1) return 128 * (nd >> 8) + (nd & 127);
    if (kind == 2) { if (nd < 1024) return (nd & ~63) + permP(nd & 63); if (nd < 2048) return nd; if (nd < 2112) return 2048 + permM(nd - 2048); return -1; }
    if (kind == 3) { const int hh = nd / 192, d = nd % 192; return hh * 192 + (d < 128 ? d : 128 + permM(d - 128)); }
    if (kind == 4) { if (nd < 1152) return (nd & ~63) + permP(nd & 63); return nd; }
    return nd;
}
DI void wt_item(gcf W, int ldw, int nsrc, int Kdim, int k0, int n0, int kind, gcf gain, bf16_t* WT, LAS float* scr, int lane) {
    const int sbase = (kind == 1) ? 128 * (n0 >> 8) : n0;
    const int c4 = (lane & 31) * 4;
    const bool okc = sbase + c4 < nsrc;
    f32x4 v[16];
#pragma unroll
    for (int i = 0; i < 16; ++i) {
        const int kk = 2 * i + (lane >> 5);
        v[i] = (f32x4){0.f, 0.f, 0.f, 0.f};
        if (okc) v[i] = *(const GAS f32x4*)(W + (size_t)(k0 + kk) * ldw + sbase + c4);
    }
#pragma unroll
    for (int i = 0; i < 16; ++i) {
        const int kk = 2 * i + (lane >> 5);
        if (gain) v[i] *= gain[k0 + kk];
        *(LAS f32x4*)(scr + kk * 132 + c4) = v[i];
    }
    asm volatile("s_waitcnt lgkmcnt(0)" ::: "memory");
    const int kq = lane >> 4;
#pragma unroll
    for (int j = 0; j < 8; ++j) {
        const int n = (lane & 15) + 16 * j;
        const int sc = srccol(kind, n0 + n);
        u32x4 o = {0u, 0u, 0u, 0u};
        if (sc >= 0) { const LAS float* s = scr + (8 * kq) * 132 + (sc - sbase);
            o.x = pk_bf16(s[0 * 132], s[1 * 132]); o.y = pk_bf16(s[2 * 132], s[3 * 132]); o.z = pk_bf16(s[4 * 132], s[5 * 132]); o.w = pk_bf16(s[6 * 132], s[7 * 132]); }
        *(u32x4*)(WT + (size_t)(n0 + n) * Kdim + k0 + 8 * kq) = o;
    }
    asm volatile("s_waitcnt lgkmcnt(0)" ::: "memory");
}
constexpr int I_GU = 32 * 44, I_DN = 88 * 8, I_FFN = I_GU + I_DN, I_WIN = 32 * 18, I_UQ = 8 * 6, I_UKV = 8 * 8, I_WO = 32 * 8, I_QKV = 32 * 10;
constexpr int W_ITEMS_L0 = 2 * I_FFN + I_WIN + I_UQ + I_UKV + I_WO, W_ITEMS = W_ITEMS_L0 + 2 * I_FFN + I_QKV + I_WO;
DI void convert_weights(unsigned char* ws, LAS unsigned char* lds, int tid, int it_lo, int it_hi, int gw, int NGW) {
    const int lane = tid & 63, wave = tid >> 6;
    LAS float* scr = (LAS float*)(lds + wave * 16896);
    bf16_t* WB = (bf16_t*)(ws + WS_W);
    for (int it = it_lo + gw; it < it_hi; it += NGW) {
        int r = it, lyr = 0;
        if (r >= W_ITEMS_L0) { r -= W_ITEMS_L0; lyr = 1; }
        if (r < 2 * I_FFN) {
            const int f = r / I_FFN, fi = 2 * lyr + f; r %= I_FFN;
            if (r < I_GU) {
                const int kb = r / 44, n0 = (r % 44) * 128;
                gcf W = (((n0 & 255) < 128) ? (f ? INP(24) : INP(3)) : (f ? INP(25) : INP(4))) + (size_t)lyr * D * FF;
                wt_item(W, FF, FF, D, kb * 32, n0, 1, (f ? INP(23) : INP(2)) + lyr * D, WB + WOFF_FFN + (size_t)fi * (W_GU + W_DN), scr, lane);
            } else {
                r -= I_GU;
                wt_item((f ? INP(26) : INP(5)) + (size_t)lyr * FF * D, D, D, FF, (r / 8) * 32, (r % 8) * 128, 0, nullptr, WB + WOFF_FFN + (size_t)fi * (W_GU + W_DN) + W_GU, scr, lane);
            }
            continue;
        }
        r -= 2 * I_FFN;
        if (lyr == 0) {
            if (r < I_WIN) { wt_item(INP(7), 2112, 2112, D, (r / 18) * 32, (r % 18) * 128, 2, INP(6), WB + WOFF_WIN, scr, lane); continue; } r -= I_WIN;
            if (r < I_UQ) { wt_item(INP(14), 768, 768, 256, (r / 6) * 32, (r % 6) * 128, 3, INP(13), WB + WOFF_UQ, scr, lane); continue; } r -= I_UQ;
            if (r < I_UKV) { wt_item(INP(16), 1024, 1024, 256, (r / 8) * 32, (r % 8) * 128, 0, INP(15), WB + WOFF_UKV, scr, lane); continue; } r -= I_UKV;
            wt_item(INP(17), 1024, 1024, D, (r / 8) * 32, (r % 8) * 128, 0, nullptr, WB + WOFF_WO0, scr, lane);
        } else {
            if (r < I_QKV) { wt_item(INP(18), 1280, 1280, D, (r / 10) * 32, (r % 10) * 128, 4, INP(6) + D, WB + WOFF_QKV, scr, lane); continue; } r -= I_QKV;
            wt_item(INP(21), 1024, 1024, D, (r / 8) * 32, (r % 8) * 128, 0, nullptr, WB + WOFF_WO1, scr, lane);
        }
    }
}

DI void prologue(const Args& a, LAS unsigned char* lds, int tid) {
    const int lane = tid & 63, wave = tid >> 6;
    const int gt = blockIdx.x * 512 + tid, nthr = gridDim.x * 512;
    const int gw = blockIdx.x * 8 + wave, NGW = gridDim.x * 8;
    float* ssq = (float*)(a.ws + WS_SSQ);
    for (int i = gt; i < 8 * R; i += nthr) ssq[R + i] = 0.f;
    if (gt < 256) ((unsigned*)(a.ws + WS_CTL))[gt] = 0u;
    {
        float2* tabP = (float2*)(a.ws + WS_TABP); float2* tabM = (float2*)(a.ws + WS_TABM);
        for (int e = gt; e < NPOS * 40; e += nthr) {
            const int pos = e / 40, i = e % 40;
            const double ex = (i < 8) ? (double)(2 * i) / 16.0 : (double)(2 * (i - 8)) / 64.0;
            const double inv = exp2(-ex * 18.931568569324174);
            double rev = (double)pos * inv * 0.15915494309189535;
            rev -= floor(rev);
            const float f = (float)rev;
            const float2 cs = make_float2(__builtin_amdgcn_cosf(f), __builtin_amdgcn_sinf(f));
            if (i < 8) tabP[pos * 8 + i] = cs; else tabM[pos * 32 + (i - 8)] = cs;
        }
    }
    { float* bp = (float*)(a.ws + WS_BQKV); gcf bq = INP(19); for (int i = gt; i < NQKV; i += nthr) bp[i] = bq[srccol(4, i)]; }
    {
        float* H = (float*)(a.ws + WS_H); bf16_t* HB = (bf16_t*)(a.ws + WS_HB);
        for (int row = gw; row < R; row += NGW) {
            const int b = row / LROW, i = row % LROW;
            gcf src = (i < NFRONT) ? nullptr : (i < 128 ? INP(1) + (size_t)(i - NFRONT) * D : INP(0) + ((size_t)b * SEQ + (i - 128)) * D);
            float s = 0.f;
#pragma unroll
            for (int j = 0; j < 4; ++j) {
                f32x4 v = {0.f, 0.f, 0.f, 0.f};
                if (src) v = *(const GAS f32x4*)(src + 256 * j + 4 * lane);
                *(f32x4*)(H + (size_t)row * D + 256 * j + 4 * lane) = v;
                u32x2 w; w.x = pk_bf16(v[0], v[1]); w.y = pk_bf16(v[2], v[3]);
                *(u32x2*)(HB + (size_t)row * D + 256 * j + 4 * lane) = w;
                s += (v[0] * v[0] + v[1] * v[1]) + (v[2] * v[2] + v[3] * v[3]);
            }
            s = wave_sum(s);
            if (lane == 0) ssq[row] = s;
        }
    }
    convert_weights(a.ws, lds, tid, 0, W_ITEMS_L0, gw, NGW);
}

__global__ void __launch_bounds__(512, 2) fwd(Args a) {
    extern __shared__ __attribute__((aligned(16))) unsigned char lds_raw[];
    LAS unsigned char* lds = (LAS unsigned char*)lds_raw;
    volatile LAS unsigned* misc = (volatile LAS unsigned*)(lds + LDS_MISC);
    cg::grid_group grid = cg::this_grid();
    int tid = threadIdx.x, bid = blockIdx.x;
    unsigned char* ws = a.ws;
#define ssq ((float*)(ws + WS_SSQ))
#define H ((float*)(ws + WS_H))
#define HB ((bf16_t*)(ws + WS_HB))
#define ACT ((bf16_t*)(ws + WS_ACT))
#define WB ((bf16_t*)(ws + WS_W))
#define tabP ((const float2*)(ws + WS_TABP))
#define tabM ((const float2*)(ws + WS_TABM))
#define QA ((bf16_t*)(ws + WS_QA))
#define KA ((bf16_t*)(ws + WS_KA))
#define VA ((bf16_t*)(ws + WS_VA))
#define QM ((bf16_t*)(ws + WS_QM))
#define CQ ((bf16_t*)(ws + WS_CQ))
#define CKV ((bf16_t*)(ws + WS_CKV))
#define KM ((bf16_t*)(ws + WS_KM))
#define OAB ((bf16_t*)((unsigned char*)a.out + OUT_OAB))
#define VM ((bf16_t*)((unsigned char*)a.out + OUT_VM))
#define QS ((bf16_t*)(ws + WS_QS))
#define KS ((bf16_t*)(ws + WS_KS))
#define VS ((bf16_t*)(ws + WS_VS))
#define OS ((bf16_t*)(ws + WS_OS))
    const int lo = a.ph_lo, hi = a.ph_hi;
#define IN(k) (lo <= (k) && (k) < hi)
#define REPS(k)
#define SEAM(k) do { if (IN(k) && IN((k) + 1)) grid.sync(); } while (0)
#define RUN_GEMM(EpiT, E, Aptr, Bptr, N_, K_) do { int k_rt = (K_); asm volatile("" : "+s"(k_rt)); pg8::Gemm g{(Aptr), (Bptr), R, (N_), k_rt}; pg8::StaticOrder S; S.init(R, (N_), (int)gridDim.x, bid); \
        pg8::gemm_phase<EpiT, pg8::StaticOrder, true, true>(lds, g, S, (E)); } while (0)

#define LAUNDER_TID() do { tid = threadIdx.x; asm volatile("" : "+v"(tid)); { size_t z_ = 0; asm volatile("" : "+s"(z_)); ws = a.ws + z_; } bid = blockIdx.x; asm volatile("" : "+s"(bid)); } while (0)
    if (IN(0)) { LAUNDER_TID(); REPS(0) { prologue(a, lds, tid); __syncthreads(); } }
    SEAM(0);
    int ph = 1;
    for (int l = 0; l < 2; ++l) {
        const bf16_t* Wgu1 = WB + WOFF_FFN + (size_t)(2 * l) * (W_GU + W_DN);
        if (IN(ph)) { LAUNDER_TID(); EpiSwiglu E{ws, 3 * l}; REPS(ph) RUN_GEMM(EpiSwiglu, E, HB, Wgu1, 5632, D); }
        SEAM(ph); ++ph;
        if (IN(ph)) { LAUNDER_TID(); EpiResid E{ws, 3 * l + 1, 0, 0.5f}; RUN_GEMM(EpiResid, E, ACT, Wgu1 + W_GU, D, FF);
            if (l == 0) {
                const int b0 = gridDim.x > 16 ? 8 : 0, nbk = (int)gridDim.x - b0;
                if (bid >= b0) convert_weights(ws, lds, tid, W_ITEMS_L0, W_ITEMS, (bid - b0) * 8 + (tid >> 6), nbk * 8);
            } }
        SEAM(ph); ++ph;
        if (l == 0) {
            if (IN(ph)) { LAUNDER_TID(); EpiWin E{ws, 0.125f * LOG2E}; RUN_GEMM(EpiWin, E, HB, WB + WOFF_WIN, NWIN, D); }
            SEAM(ph); ++ph;
            if (IN(ph)) { LAUNDER_TID();
                REPS(ph) { EpiUq E{ws, 0.07216878364870322f * LOG2E}; RUN_GEMM(EpiUq, E, CQ, WB + WOFF_UQ, NUQ, 256); }
                REPS(ph) { EpiUkv E{ws, (unsigned char*)a.out}; RUN_GEMM(EpiUkv, E, CKV, WB + WOFF_UKV, NUKV, 256); }
            }
            SEAM(ph); ++ph;
            if (IN(ph)) { LAUNDER_TID();
                LAUNDER_TID();
                if (tid < 64) {
                    const float s1 = wave_sum(INP(8)[tid] * INP(9)[tid]), s2 = wave_sum(INP(10)[tid] * INP(11)[tid]);
                    if (tid == 0) misc[1] = __float_as_uint(__expf(s1) - __expf(s2) + 0.2f);
                }
                __syncthreads();
                AttnL0 A{QA, KA, VA, QM, KM, VM, OAB, INP(12), __uint_as_float(misc[1])};
                unsigned* qctr = (unsigned*)(ws + WS_CTL);
                REPS(ph) {
                for (;;) {
                    if (tid == 0) misc[0] = atomicAdd(qctr, 1u);
                    __syncthreads();
                    const unsigned idx = misc[0];
                    __syncthreads();
                    if (idx >= 33u * 16u) break;
                    const int t = 32 - (int)(idx >> 4), rem = idx & 15;
                    attn_unit_diff(lds, A, rem & 3, rem >> 2, t, tid);
                }
                asm volatile("" ::: "memory");
                for (;;) {
                    if (tid == 0) misc[0] = atomicAdd(qctr + 64, 1u);
                    __syncthreads();
                    const unsigned idx = misc[0];
                    __syncthreads();
                    if (idx >= 33u * 16u) break;
                    const int t = 32 - (int)(idx >> 4), rem = idx & 15;
                    attn_unit_mla(lds, A, rem & 3, rem >> 2, t, tid);
                }
                }
            }
            SEAM(ph); ++ph;
            if (IN(ph)) { LAUNDER_TID(); EpiResid E{ws, 2, 0, 1.0f}; RUN_GEMM(EpiResid, E, OAB, WB + WOFF_WO0, D, D); }
            SEAM(ph); ++ph;
        } else {
            if (IN(ph)) { LAUNDER_TID(); EpiQkvS E{ws, 0.125f * LOG2E}; RUN_GEMM(EpiQkvS, E, HB, WB + WOFF_QKV, NQKV, D); }
            SEAM(ph); ++ph;
            if (IN(ph)) { LAUNDER_TID();
                LAUNDER_TID();
                AttnL1 A{QS, KS, VS, OS, INP(20)};
                REPS(ph) for (int u = bid; u < NB * 2 * 65; u += gridDim.x) { const int b = u / 130, rem = u % 130; attn_unit_swa(lds, A, b, rem / 65, rem % 65, tid); }
            }
            SEAM(ph); ++ph;
            if (IN(ph)) { LAUNDER_TID(); EpiResid E{ws, 5, 1, 1.0f}; RUN_GEMM(EpiResid, E, OS, WB + WOFF_WO1, D, D); }
            SEAM(ph); ++ph;
        }
        const bf16_t* Wgu2 = WB + WOFF_FFN + (size_t)(2 * l + 1) * (W_GU + W_DN);
        if (IN(ph)) { LAUNDER_TID(); EpiSwiglu E{ws, 3 * l + 2}; REPS(ph) RUN_GEMM(EpiSwiglu, E, HB, Wgu2, 5632, D); }
        SEAM(ph); ++ph;
        if (IN(ph)) { LAUNDER_TID(); EpiResid E{ws, 3 * l + 3, 0, 0.5f}; RUN_GEMM(EpiResid, E, ACT, Wgu2 + W_GU, D, FF); }
        SEAM(ph); ++ph;
    }
    if (IN(ph)) { LAUNDER_TID();
        LAUNDER_TID();
        const int lane = tid & 63, gw = bid * 8 + (tid >> 6), NGW = gridDim.x * 8;
        gcf gf = INP(27);
        REPS(ph) for (int s = gw; s < NB * SEQ; s += NGW) {
            const int row = (s / SEQ) * LROW + 128 + (s % SEQ);
            const float rstd = rsqrtf(ssq[(size_t)6 * R + row] * (1.0f / D) + EPS);
#pragma unroll
            for (int j = 0; j < 4; ++j) {
                const f32x4 v = *(const f32x4*)(H + (size_t)row * D + 256 * j + 4 * lane), gg = *(const GAS f32x4*)(gf + 256 * j + 4 * lane);
                *(f32x4*)(a.out + (size_t)s * D + 256 * j + 4 * lane) = v * rstd * gg;
            }
        }
    }
}
constexpr int NPH = 17;

extern "C" void kernel_launch(void* const* d_in, const int* in_sizes, int n_in, void* d_out, int out_size, void* d_ws, size_t ws_size, hipStream_t stream) {
    static int grid = 0;
    if (grid == 0) {
        if (n_in != 28 || out_size != NB * SEQ * D || ws_size < WS_END) { fprintf(stderr, "kernel_launch: unexpected problem (n_in %d out %d ws %zu)\n", n_in, out_size, ws_size); grid = -1; return; }
        int dev = 0, cus = 0, per = 0;
        (void)hipGetDevice(&dev); (void)hipDeviceGetAttribute(&cus, hipDeviceAttributeMultiprocessorCount, dev);
        (void)hipFuncSetAttribute((const void*)fwd, hipFuncAttributeMaxDynamicSharedMemorySize, LDS_BYTES);
        (void)hipOccupancyMaxActiveBlocksPerMultiprocessor(&per, (const void*)fwd, 512, LDS_BYTES);
        (void)hipGetLastError();
        grid = cus > 0 ? cus : 256;
    }
    if (grid < 0) return;
    Args a{};
    for (int i = 0; i < 28; ++i) a.in[i] = (const float*)d_in[i];
    a.out = (float*)d_out; a.ws = (unsigned char*)d_ws;
#if MK_PER_PHASE
    for (int p = 0; p < NPH; ++p) {
        const int reps = ((PROBE_MASK >> p) & 1u) ? PROBE_N : 1;
        for (int r = 0; r < reps; ++r) {
            if (p == 5 && r > 0) (void)hipMemsetAsync(d_ws, 0, 1024, stream);
            a.ph_lo = p; a.ph_hi = p + 1; hipLaunchKernelGGL(fwd, dim3(grid), dim3(512), LDS_BYTES, stream, a);
        }
    }
#else
    a.ph_lo = 0; a.ph_hi = NPH;
    void* args[] = {&a};
    hipError_t e = hipLaunchCooperativeKernel((const void*)fwd, dim3(grid), dim3(512), args, LDS_BYTES, stream);
    if (e != hipSuccess) fprintf(stderr, "cooperative launch failed: %s (grid %d)\n", hipGetErrorString(e), grid);
#endif
}
```

```cpp
#include <hip/hip_runtime.h>
#include <hip/hip_cooperative_groups.h>
#include <cstdio>
#include <cstdint>
#include <cmath>
namespace cg = cooperative_groups;
#ifndef MK_PER_PHASE
#define MK_PER_PHASE 0
#endif
#ifndef PROBE_MASK
#define PROBE_MASK 0u
#endif
#ifndef PROBE_N
#define PROBE_N 2
#endif
namespace pg8 {
#define PG8_LAS __attribute__((address_space(3)))
typedef unsigned short bf16_t;
typedef short bf16x8 __attribute__((ext_vector_type(8)));
typedef float f32x4 __attribute__((ext_vector_type(4)));
typedef unsigned u32x4 __attribute__((ext_vector_type(4)));
constexpr int BM = 256, BK = 64, HALF = 128, HTB = HALF * BK * 2  , STAGE_BYTES = 8 * HTB, NXCD = 8, WGM = 8;

__host__ __device__ __forceinline__ int lds_byte(int r, int c) { const int st = (r >> 4) * 2 + (c >> 5), rr = r & 15, cc = c & 31, ob = rr * 64 + cc * 2; return st * 1024 + (ob ^ (((ob >> 9) & 1) << 5)); }
__host__ __device__ __forceinline__ void stage_rc(int b, int& R, int& C) { const int st = b / 1024, sb = b % 1024, swz = sb ^ (((sb >> 9) & 1) << 5); R = (st >> 1) * 16 + swz / 64; C = (st & 1) * 32 + (swz % 64) / 2; }
__host__ __device__ __forceinline__ int perm32(int rho) { const int n = rho >> 4, i = rho & 15; return 8 * (i >> 2) + 4 * n + (i & 3); }

struct Unit { int pm, pn; };
struct Gemm { const bf16_t* A; const bf16_t* Bt; int M, N, K; };

struct StaticOrder {
    int nM, nN, nwg, G, c;
    __host__ __device__ void init(int M, int N, int G_, int c_) { nM = M / BM; nN = N / BM; nwg = nM * nN; G = G_; c = c_; }
    __host__ __device__ bool next(int i, Unit& u) const {
        const long L = (long)i * G + c; if (L >= nwg) return false;
        int wgid = (int)L; { const int q = nwg / NXCD, r = nwg % NXCD, xcd = wgid % NXCD, off = wgid / NXCD; wgid = (xcd < r ? xcd * (q + 1) : r * (q + 1) + (xcd - r) * q) + off; }
        const int nig = WGM * nN, gid = wgid / nig, fm = gid * WGM, gsz = (nM - fm) < WGM ? (nM - fm) : WGM;
        u.pm = fm + ((wgid % nig) % gsz); u.pn = (wgid % nig) / gsz; return true;
    }
    __device__ __forceinline__ void a_ready(const Unit&) const {}
    __device__ __forceinline__ void done(const Unit&) const {}
};

__device__ __forceinline__ unsigned cvt_pk_bf16(float lo, float hi) { unsigned r; asm volatile("v_cvt_pk_bf16_f32 %0, %1, %2" : "=v"(r) : "v"(lo), "v"(hi)); return r; }
template <class Epi, class Sched, bool ALIGN_EPI = false, bool SP2 = false>
__device__ __forceinline__ void gemm_phase(PG8_LAS unsigned char* lds, const Gemm g, const Sched& S, const Epi& E) {
    int tid_l = threadIdx.x; asm volatile("" : "+v"(tid_l)); const int tid = tid_l, wid = __builtin_amdgcn_readfirstlane(tid >> 6), lane = tid & 63, wr = wid >> 2, wc = wid & 3, fr = lane & 15, fq = lane >> 4;
    const int K = g.K, nt = K / BK;
    unsigned voffA[2], voffB[2];
#pragma unroll
    for (int i = 0; i < 2; ++i) { int R, C; stage_rc(tid * 16 + i * 8192, R, C); const int Rb = Epi::PERM ? ((R & ~31) + perm32(R & 31)) : R;
        voffA[i] = (unsigned)(R * K + C) * 2u; voffB[i] = (unsigned)(Rb * K + C) * 2u; }
    const size_t kstep = (size_t)(BK * 2);
    const size_t hstep = (size_t)HALF * K * 2;
    const size_t tstep = 2 * hstep;
    const unsigned ldsw = (unsigned)wid * 1024u;
    const int aoff = lds_byte(wr * 64 + fr, fq * 8), boff = lds_byte(wc * 32 + fr, fq * 8);
#define PG8_SA(b, h) (((b) * 2 + (h)) * HTB)
#define PG8_SB(b, h) ((4 + (b) * 2 + (h)) * HTB)
#define PG8_STAGE(bufoff, gbase, voff) do { _Pragma("unroll") for (int _i = 0; _i < 2; ++_i) \
        __builtin_amdgcn_global_load_lds((const unsigned*)((const char*)(gbase) + (voff)[_i]), (PG8_LAS unsigned*)(lds + (bufoff) + ldsw + _i * 8192), 16, 0, 0); } while (0)
#define PG8_LDA(dst, b, h) do { _Pragma("unroll") for (int m = 0; m < 4; ++m) _Pragma("unroll") for (int k = 0; k < 2; ++k) dst[m][k] = *(const PG8_LAS bf16x8*)(lds + PG8_SA(b, h) + aoff + m * 2048 + k * 1024); } while (0)
#define PG8_LDB(dst, b, h) do { _Pragma("unroll") for (int n = 0; n < 2; ++n) _Pragma("unroll") for (int k = 0; k < 2; ++k) dst[n][k] = *(const PG8_LAS bf16x8*)(lds + PG8_SB(b, h) + boff + n * 2048 + k * 1024); } while (0)
#define PG8_MMA(ai, bj, At, Bt) do { __builtin_amdgcn_s_setprio(1); _Pragma("unroll") for (int m = 0; m < 4; ++m) _Pragma("unroll") for (int n = 0; n < 2; ++n) _Pragma("unroll") for (int k = 0; k < 2; ++k) \
        acc[ai][bj][m][n] = __builtin_amdgcn_mfma_f32_16x16x32_bf16(Bt[n][k], At[m][k], acc[ai][bj][m][n], 0, 0, 0); __builtin_amdgcn_s_setprio(0); } while (0)
#define PG8_WAIT_V(n) asm volatile("s_waitcnt vmcnt(" #n ")" ::: "memory")
#define PG8_WAIT_L(n) asm volatile("s_waitcnt lgkmcnt(" #n ")" ::: "memory")
#define PG8_BAR __builtin_amdgcn_s_barrier()
#define PG8_SCHED __builtin_amdgcn_sched_barrier(0)
    Unit cur, nxt; int ui = 0;
    if (!S.next(0, cur)) return;
    f32x4 acc[2][2][4][2];
#pragma unroll
    for (int a = 0; a < 2; ++a)
#pragma unroll
        for (int b = 0; b < 2; ++b)
#pragma unroll
            for (int m = 0; m < 4; ++m)
#pragma unroll
                for (int n = 0; n < 2; ++n) acc[a][b][m][n] = (f32x4){0.f, 0.f, 0.f, 0.f};
    bf16x8 At[4][2], B0[2][2], B1[2][2];
    const char* cA = (const char*)g.A + (size_t)cur.pm * tstep; const char* cB = (const char*)g.Bt + (size_t)cur.pn * tstep;
    S.a_ready(cur);
    if constexpr (SP2) {
        PG8_STAGE(PG8_SB(0, 0), cB, voffB); PG8_STAGE(PG8_SB(0, 1), cB + hstep, voffB); PG8_STAGE(PG8_SA(0, 0), cA, voffA); PG8_STAGE(PG8_SA(0, 1), cA + hstep, voffA);
        if (wr == 1) PG8_BAR;
        PG8_WAIT_V(2); PG8_BAR;
        PG8_STAGE(PG8_SB(1, 0), cB + kstep, voffB); PG8_STAGE(PG8_SA(1, 0), cA + kstep, voffA); PG8_STAGE(PG8_SB(1, 1), cB + hstep + kstep, voffB);
        PG8_WAIT_V(6); PG8_BAR;
    } else {
        PG8_STAGE(PG8_SB(0, 0), cB, voffB); PG8_STAGE(PG8_SA(0, 0), cA, voffA); PG8_STAGE(PG8_SB(0, 1), cB + hstep, voffB); PG8_STAGE(PG8_SA(0, 1), cA + hstep, voffA);
        if (wr == 1) PG8_BAR;
        PG8_WAIT_V(4); PG8_BAR;
        PG8_STAGE(PG8_SB(1, 0), cB + kstep, voffB); PG8_STAGE(PG8_SA(1, 0), cA + kstep, voffA); PG8_STAGE(PG8_SB(1, 1), cB + hstep + kstep, voffB);
        PG8_WAIT_V(6); PG8_BAR;
    }
    for (;;) {
        const bool has_next = S.next(ui + 1, nxt);
        const char* nA = has_next ? (const char*)g.A + (size_t)nxt.pm * tstep : cA; const char* nB = has_next ? (const char*)g.Bt + (size_t)nxt.pn * tstep : cB;
        for (int t = 0; t < nt; t += 2) {
            const bool last = (t == nt - 2);
            const char* a1 = cA + (size_t)(t + 1) * kstep;
            const char* a2 = last ? nA : cA + (size_t)(t + 2) * kstep; const char* b2 = last ? nB : cB + (size_t)(t + 2) * kstep;
            const char* a3 = a2 + kstep; const char* b3 = b2 + kstep;
            if (last && has_next) S.a_ready(nxt);
            if constexpr (SP2) {
            PG8_LDB(B0, 0, 0); PG8_LDB(B1, 0, 1); PG8_SCHED; PG8_LDA(At, 0, 0); PG8_STAGE(PG8_SA(1, 1), a1 + hstep, voffA);
            PG8_WAIT_V(8); PG8_WAIT_L(0); PG8_BAR; PG8_MMA(0, 0, At, B0); PG8_MMA(0, 1, At, B1); PG8_BAR; PG8_SCHED;
            PG8_LDA(At, 0, 1); PG8_STAGE(PG8_SB(0, 0), b2, voffB); PG8_STAGE(PG8_SB(0, 1), b2 + hstep, voffB); PG8_STAGE(PG8_SA(0, 0), a2, voffA);
            PG8_WAIT_V(8); PG8_WAIT_L(0); PG8_BAR; PG8_MMA(1, 0, At, B0); PG8_MMA(1, 1, At, B1); PG8_BAR; PG8_SCHED;
            PG8_LDB(B0, 1, 0); PG8_LDB(B1, 1, 1); PG8_SCHED; PG8_LDA(At, 1, 0); PG8_STAGE(PG8_SA(0, 1), a2 + hstep, voffA);
            PG8_WAIT_V(8); PG8_WAIT_L(0); PG8_BAR; PG8_MMA(0, 0, At, B0); PG8_MMA(0, 1, At, B1); PG8_BAR; PG8_SCHED;
            PG8_LDA(At, 1, 1); PG8_STAGE(PG8_SB(1, 0), b3, voffB); PG8_STAGE(PG8_SB(1, 1), b3 + hstep, voffB); PG8_STAGE(PG8_SA(1, 0), a3, voffA);
            PG8_WAIT_V(8); PG8_WAIT_L(0); PG8_BAR; PG8_MMA(1, 0, At, B0); PG8_MMA(1, 1, At, B1); PG8_BAR; PG8_SCHED;
            } else {
            PG8_LDB(B0, 0, 0); PG8_SCHED; PG8_LDA(At, 0, 0); PG8_STAGE(PG8_SA(1, 1), a1 + hstep, voffA);
            PG8_WAIT_L(8); PG8_BAR; PG8_WAIT_L(0); PG8_MMA(0, 0, At, B0); PG8_BAR; PG8_SCHED;
            PG8_LDB(B1, 0, 1); PG8_STAGE(PG8_SB(0, 0), b2, voffB);
            PG8_BAR; PG8_WAIT_L(0); PG8_MMA(0, 1, At, B1); PG8_BAR;
            PG8_LDA(At, 0, 1); PG8_STAGE(PG8_SA(0, 0), a2, voffA);
            PG8_BAR; PG8_WAIT_L(0); PG8_MMA(1, 0, At, B0); PG8_BAR; PG8_SCHED;
            PG8_STAGE(PG8_SB(0, 1), b2 + hstep, voffB);
            PG8_WAIT_V(6); PG8_BAR; PG8_MMA(1, 1, At, B1); PG8_BAR;
            PG8_LDB(B0, 1, 0); PG8_SCHED; PG8_LDA(At, 1, 0); PG8_STAGE(PG8_SA(0, 1), a2 + hstep, voffA);
            PG8_WAIT_L(8); PG8_BAR; PG8_WAIT_L(0); PG8_MMA(0, 0, At, B0); PG8_BAR; PG8_SCHED;
            PG8_LDB(B1, 1, 1); PG8_STAGE(PG8_SB(1, 0), b3, voffB);
            PG8_BAR; PG8_WAIT_L(0); PG8_MMA(0, 1, At, B1); PG8_BAR;
            PG8_LDA(At, 1, 1); PG8_STAGE(PG8_SA(1, 0), a3, voffA);
            PG8_BAR; PG8_WAIT_L(0); PG8_MMA(1, 0, At, B0); PG8_BAR; PG8_SCHED;
            PG8_STAGE(PG8_SB(1, 1), b3 + hstep, voffB);
            PG8_WAIT_V(6); PG8_BAR; PG8_MMA(1, 1, At, B1); PG8_BAR;
            }
        }
        if constexpr (ALIGN_EPI) { if (wr == 0) PG8_BAR; }
        if constexpr (!Epi::AFTER_DRAIN) { E(acc, cur, wr, wc, fr, fq); S.done(cur); }
        if (!has_next) break;
#pragma unroll
        for (int a = 0; a < 2; ++a)
#pragma unroll
            for (int b = 0; b < 2; ++b)
#pragma unroll
                for (int m = 0; m < 4; ++m)
#pragma unroll
                    for (int n = 0; n < 2; ++n) acc[a][b][m][n] = (f32x4){0.f, 0.f, 0.f, 0.f};
        cur = nxt; cA = nA; cB = nB; ++ui;
        if constexpr (ALIGN_EPI) { if (wr == 1) PG8_BAR; }
    }
    PG8_WAIT_V(0);
    if constexpr (!ALIGN_EPI) { if (wr == 0) PG8_BAR; }
    PG8_BAR;
    if constexpr (Epi::AFTER_DRAIN) { E.fused(acc, cur, wr, wc, fr, fq, lds, wid, lane); S.done(cur); }
#undef PG8_SA
#undef PG8_SB
#undef PG8_STAGE
#undef PG8_LDA
#undef PG8_LDB
#undef PG8_MMA
#undef PG8_WAIT_V
#undef PG8_WAIT_L
#undef PG8_BAR
#undef PG8_SCHED
}
}
#define LAS __attribute__((address_space(3)))
#define DI __device__ __forceinline__
typedef unsigned short bf16_t;
typedef short bf16x8 __attribute__((ext_vector_type(8)));
typedef short s16x4 __attribute__((ext_vector_type(4)));
typedef float f32x4 __attribute__((ext_vector_type(4)));
typedef float f32x16 __attribute__((ext_vector_type(16)));
typedef unsigned u32x4 __attribute__((ext_vector_type(4)));
typedef unsigned u32x2 __attribute__((ext_vector_type(2)));
typedef float f32x2_t __attribute__((ext_vector_type(2)));
typedef __bf16 bf16x2_t __attribute__((ext_vector_type(2)));

constexpr int NB = 4, SEQ = 8192, LROW = 8320, R = NB * LROW, D = 1024, FF = 2816, NFRONT = 112, NPOS = 8208;
constexpr int NWIN = 2304, NUQ = 768, NUKV = 1024, NQKV = 1280;
constexpr float LOG2E = 1.4426950408889634f;
constexpr float NEGBIG = -1e30f;
constexpr float EPS = 1e-6f;

constexpr size_t MiB = 1u << 20;
constexpr size_t WS_CTL = 0;
constexpr size_t WS_SSQ = 1 * MiB;
constexpr size_t WS_TABP = 3 * MiB;
constexpr size_t WS_TABM = WS_TABP + 768 * 1024;
constexpr size_t WS_W = 6 * MiB;
constexpr size_t W_GU = (size_t)5632 * 1024, W_DN = (size_t)1024 * 2816;
constexpr size_t WOFF_FFN = 0;
constexpr size_t WOFF_WIN = 4 * (W_GU + W_DN);
constexpr size_t WOFF_UQ = WOFF_WIN + (size_t)NWIN * 1024;
constexpr size_t WOFF_UKV = WOFF_UQ + (size_t)NUQ * 256;
constexpr size_t WOFF_WO0 = WOFF_UKV + (size_t)NUKV * 256;
constexpr size_t WOFF_QKV = WOFF_WO0 + (size_t)1024 * 1024;
constexpr size_t WOFF_WO1 = WOFF_QKV + (size_t)NQKV * 1024;
constexpr size_t W_TOTAL = WOFF_WO1 + (size_t)1024 * 1024;
constexpr size_t WS_BQKV = WS_W + 80 * MiB;
static_assert(W_TOTAL * 2 <= 79 * MiB, "weights fit");
constexpr size_t WS_H = 87 * MiB;
constexpr size_t WS_HB = WS_H + (size_t)R * D * 4;
constexpr size_t WS_ACT = WS_HB + (size_t)R * D * 2;
constexpr size_t SZ512 = (size_t)R * 512 * 2, SZ768 = (size_t)R * 768 * 2, SZ256 = (size_t)R * 256 * 2;
constexpr size_t WS_QA = WS_ACT, WS_KA = WS_QA + SZ512, WS_VA = WS_KA + SZ512, WS_QM = WS_VA + SZ512, WS_CQ = WS_QM + SZ768, WS_CKV = WS_CQ + SZ256;
static_assert(WS_CKV + SZ256 <= WS_ACT + (size_t)R * FF * 2, "layer-0 attention inputs overlay act");
constexpr size_t WS_KM = WS_ACT + (size_t)R * FF * 2;
constexpr size_t WS_END = WS_KM + SZ768;
static_assert(WS_END <= 512 * MiB, "d_ws map fits 512 MiB");
constexpr size_t WS_QS = WS_ACT, WS_KS = WS_QS + (size_t)R * 1024 * 2, WS_VS = WS_KS + (size_t)R * 128 * 2, WS_OS = WS_VS + (size_t)R * 128 * 2;
static_assert(WS_OS + (size_t)R * 1024 * 2 <= WS_KM, "layer-1 attention buffers overlay act");
constexpr size_t OUT_OAB = 0, OUT_VM = (size_t)R * 1024 * 2;
static_assert(OUT_VM + SZ512 <= (size_t)NB * SEQ * D * 4, "d_out scratch");

constexpr int LDS_BYTES = 147456, LDS_MISC = 131072;

struct Args {
    const float* in[28]; float* out; unsigned char* ws; int ph_lo, ph_hi;
};

#define GAS __attribute__((address_space(1)))
typedef const GAS float* gcf;
DI gcf INP(int i) { asm volatile("" : "+s"(i)); return ((const gcf*)__builtin_amdgcn_kernarg_segment_ptr())[i]; }
DI unsigned pk_bf16(float lo, float hi) { f32x2_t v = {lo, hi}; bf16x2_t b = __builtin_convertvector(v, bf16x2_t); return __builtin_bit_cast(unsigned, b); }
DI float bf_lo(unsigned u) { return __uint_as_float(u << 16); }
DI float bf_hi(unsigned u) { return __uint_as_float(u & 0xffff0000u); }
DI int row_pos(int row) { const int i = row % LROW; return i > NFRONT ? i - NFRONT : 0; }
DI int permP(int d) { return d < 16 ? ((d & 1) ? (d >> 1) + 8 : (d >> 1)) : d; }
DI int permM(int d) { return (d & 1) ? (d >> 1) + 32 : (d >> 1); }
DI float wave_sum(float v) {
#pragma unroll
    for (int o = 1; o < 64; o <<= 1) v += __shfl_xor(v, o);
    return v;
}
DI void rope8(f32x4& v0, f32x4& v1, const float2* tab) {
    const float2 t0 = tab[0], t1 = tab[1], t2 = tab[2], t3 = tab[3];
    f32x4 a = v0, b = v1;
    v0[0] = a[0] * t0.x - a[1] * t0.y; v0[1] = a[1] * t0.x + a[0] * t0.y;
    v0[2] = a[2] * t1.x - a[3] * t1.y; v0[3] = a[3] * t1.x + a[2] * t1.y;
    v1[0] = b[0] * t2.x - b[1] * t2.y; v1[1] = b[1] * t2.x + b[0] * t2.y;
    v1[2] = b[2] * t3.x - b[3] * t3.y; v1[3] = b[3] * t3.x + b[2] * t3.y;
}
DI u32x4 pack8(const f32x4& a, const f32x4& b) { u32x4 w; w.x = pk_bf16(a[0], a[1]); w.y = pk_bf16(a[2], a[3]); w.z = pk_bf16(b[0], b[1]); w.w = pk_bf16(b[2], b[3]); return w; }

#define EPI_ROW(ai, m) (u.pm * 256 + (ai) * 128 + wr * 64 + (m) * 16 + fr)
typedef const f32x4 (&AccRef)[2][2][4][2];

struct EpiSwiglu {
    static constexpr bool PERM = true, AFTER_DRAIN = false;
    unsigned char* ws; int ssq_idx;
    DI void operator()(AccRef acc, const pg8::Unit& u, int wr, int wc, int fr, int fq) const {
        bf16_t* O = (bf16_t*)(ws + WS_ACT); const float* ssq = (const float*)(ws + WS_SSQ) + (size_t)ssq_idx * R;
        const int f0 = u.pn * 128 + wc * 32 + fq * 8;
#pragma unroll
        for (int ai = 0; ai < 2; ++ai)
#pragma unroll
            for (int m = 0; m < 4; ++m) {
                const int row = EPI_ROW(ai, m); asm volatile("" ::: "memory");
                const float rstd = rsqrtf(ssq[row] * (1.0f / D) + EPS);
                f32x4 o[2];
#pragma unroll
                for (int n = 0; n < 2; ++n) {
                    const f32x4 g = acc[ai][0][m][n] * rstd, up = acc[ai][1][m][n] * rstd;
#pragma unroll
                    for (int e = 0; e < 4; ++e) o[n][e] = g[e] * __builtin_amdgcn_rcpf(1.0f + __builtin_amdgcn_exp2f(-g[e] * LOG2E)) * up[e];
                }
                *(u32x4*)(O + (size_t)row * FF + f0) = pack8(o[0], o[1]);
            }
    }
};

struct EpiResid {
    static constexpr bool PERM = true, AFTER_DRAIN = false;
    unsigned char* ws; int ssq_idx; int has_bias; float alpha;
    DI void operator()(AccRef acc, const pg8::Unit& u, int wr, int wc, int fr, int fq) const {
        float* h = (float*)(ws + WS_H); bf16_t* hb = (bf16_t*)(ws + WS_HB); float* ssq_out = (float*)(ws + WS_SSQ) + (size_t)ssq_idx * R; gcf bias = has_bias ? INP(22) : nullptr;
#pragma unroll
        for (int ai = 0; ai < 2; ++ai)
#pragma unroll
            for (int m = 0; m < 4; ++m) {
                const int row = EPI_ROW(ai, m); if (m == 0) asm volatile("" ::: "memory");
                float ss = 0.f;
#pragma unroll
                for (int bj = 0; bj < 2; ++bj) {
                    const int c = u.pn * 256 + bj * 128 + wc * 32 + fq * 8;
                    float* hp = h + (size_t)row * D + c;
                    f32x4 h0 = __builtin_nontemporal_load((const f32x4*)hp), h1 = __builtin_nontemporal_load((const f32x4*)(hp + 4));
                    h0 += acc[ai][bj][m][0] * alpha; h1 += acc[ai][bj][m][1] * alpha;
                    if (bias) { h0 += *(const GAS f32x4*)(bias + c); h1 += *(const GAS f32x4*)(bias + c + 4); }
                    __builtin_nontemporal_store(h0, (f32x4*)hp); __builtin_nontemporal_store(h1, (f32x4*)(hp + 4));
                    *(u32x4*)(hb + (size_t)row * D + c) = pack8(h0, h1);
                    ss += (h0[0] * h0[0] + h0[1] * h0[1]) + (h0[2] * h0[2] + h0[3] * h0[3]) + (h1[0] * h1[0] + h1[1] * h1[1]) + (h1[2] * h1[2] + h1[3] * h1[3]);
                }
                ss += __shfl_xor(ss, 16); ss += __shfl_xor(ss, 32);
                if (fq == 0) atomicAdd(ssq_out + row, ss);
            }
    }
};

struct EpiWin {
    static constexpr bool PERM = true, AFTER_DRAIN = false;
    unsigned char* ws; float qscale;
    DI void operator()(AccRef acc, const pg8::Unit& u, int wr, int wc, int fr, int fq) const {
        const float* ssq = (const float*)(ws + WS_SSQ) + (size_t)1 * R; float* ssq_cq = (float*)(ws + WS_SSQ) + (size_t)7 * R; float* ssq_ckv = (float*)(ws + WS_SSQ) + (size_t)8 * R;
        bf16_t *QA = (bf16_t*)(ws + WS_QA), *KA = (bf16_t*)(ws + WS_KA), *VA = (bf16_t*)(ws + WS_VA), *CQ = (bf16_t*)(ws + WS_CQ), *CKV = (bf16_t*)(ws + WS_CKV), *KM = (bf16_t*)(ws + WS_KM);
        const float2* tabP = (const float2*)(ws + WS_TABP); const float2* tabM = (const float2*)(ws + WS_TABM);
        const int pn = u.pn;
#pragma unroll
        for (int ai = 0; ai < 2; ++ai)
#pragma unroll
            for (int m = 0; m < 4; ++m) {
                const int row = EPI_ROW(ai, m); asm volatile("" ::: "memory");
                const int pos = row_pos(row);
                const float rstd = rsqrtf(ssq[row] * (1.0f / D) + EPS);
                float ss = 0.f;
#pragma unroll
                for (int bj = 0; bj < 2; ++bj) {
                    const int cl = bj * 128 + wc * 32 + fq * 8;
                    f32x4 v0 = acc[ai][bj][m][0] * rstd, v1 = acc[ai][bj][m][1] * rstd;
                    if (pn < 4) {
                        if ((cl & 63) < 16) rope8(v0, v1, tabP + pos * 8 + ((cl & 63) >> 1));
                        if (pn < 2) { v0 *= qscale; v1 *= qscale; }
                        bf16_t* dst = (pn < 2 ? QA : KA) + (size_t)row * 512 + (pn & 1) * 256 + cl;
                        *(u32x4*)dst = pack8(v0, v1);
                    } else if (pn < 6) {
                        *(u32x4*)(VA + (size_t)row * 512 + (pn - 4) * 256 + cl) = pack8(v0, v1);
                    } else if (pn < 8) {
                        *(u32x4*)((pn == 6 ? CQ : CKV) + (size_t)row * 256 + cl) = pack8(v0, v1);
                        ss += (v0[0] * v0[0] + v0[1] * v0[1]) + (v0[2] * v0[2] + v0[3] * v0[3]) + (v1[0] * v1[0] + v1[1] * v1[1]) + (v1[2] * v1[2] + v1[3] * v1[3]);
                    } else if (cl < 64) {
                        rope8(v0, v1, tabM + pos * 32 + (cl >> 1));
                        const u32x4 w = pack8(v0, v1);
#pragma unroll
                        for (int hh = 0; hh < 4; ++hh) *(u32x4*)(KM + (size_t)row * 768 + hh * 192 + 128 + cl) = w;
                    }
                }
                if (pn == 6 || pn == 7) {
                    ss += __shfl_xor(ss, 16); ss += __shfl_xor(ss, 32);
                    if (fq == 0) atomicAdd((pn == 6 ? ssq_cq : ssq_ckv) + row, ss);
                }
            }
    }
};

struct EpiUq {
    static constexpr bool PERM = true, AFTER_DRAIN = false;
    unsigned char* ws; float qscale;
    DI void operator()(AccRef acc, const pg8::Unit& u, int wr, int wc, int fr, int fq) const {
        const float* ssq_cq = (const float*)(ws + WS_SSQ) + (size_t)7 * R; bf16_t* QM = (bf16_t*)(ws + WS_QM); const float2* tabM = (const float2*)(ws + WS_TABM);
#pragma unroll
        for (int ai = 0; ai < 2; ++ai)
#pragma unroll
            for (int m = 0; m < 4; ++m) {
                const int row = EPI_ROW(ai, m); asm volatile("" ::: "memory");
                const int pos = row_pos(row);
                const float rstd = rsqrtf(ssq_cq[row] * (1.0f / 256) + EPS);
#pragma unroll
                for (int bj = 0; bj < 2; ++bj) {
                    const int c = u.pn * 256 + bj * 128 + wc * 32 + fq * 8;
                    const int d = c % 192;
                    f32x4 v0 = acc[ai][bj][m][0] * rstd, v1 = acc[ai][bj][m][1] * rstd;
                    if (d >= 128) rope8(v0, v1, tabM + pos * 32 + ((d - 128) >> 1));
                    v0 *= qscale; v1 *= qscale;
                    *(u32x4*)(QM + (size_t)row * 768 + c) = pack8(v0, v1);
                }
            }
    }
};

struct EpiUkv {
    static constexpr bool PERM = true, AFTER_DRAIN = false;
    unsigned char* ws; unsigned char* outb;
    DI void operator()(AccRef acc, const pg8::Unit& u, int wr, int wc, int fr, int fq) const {
        const float* ssq_ckv = (const float*)(ws + WS_SSQ) + (size_t)8 * R; bf16_t* KM = (bf16_t*)(ws + WS_KM); bf16_t* VM = (bf16_t*)(outb + OUT_VM);
#pragma unroll
        for (int ai = 0; ai < 2; ++ai)
#pragma unroll
            for (int m = 0; m < 4; ++m) {
                const int row = EPI_ROW(ai, m); asm volatile("" ::: "memory");
                const float rstd = rsqrtf(ssq_ckv[row] * (1.0f / 256) + EPS);
                const int cl = wc * 32 + fq * 8;
                *(u32x4*)(KM + (size_t)row * 768 + u.pn * 192 + cl) = pack8(acc[ai][0][m][0] * rstd, acc[ai][0][m][1] * rstd);
                *(u32x4*)(VM + (size_t)row * 512 + u.pn * 128 + cl) = pack8(acc[ai][1][m][0] * rstd, acc[ai][1][m][1] * rstd);
            }
    }
};

struct EpiQkvS {
    static constexpr bool PERM = true, AFTER_DRAIN = false;
    unsigned char* ws; float qscale;
    DI void operator()(AccRef acc, const pg8::Unit& u, int wr, int wc, int fr, int fq) const {
        const float* ssq = (const float*)(ws + WS_SSQ) + (size_t)4 * R; const float* bias = (const float*)(ws + WS_BQKV); bf16_t *QS = (bf16_t*)(ws + WS_QS), *KS = (bf16_t*)(ws + WS_KS), *VS = (bf16_t*)(ws + WS_VS); const float2* tabP = (const float2*)(ws + WS_TABP);
        const int pn = u.pn;
#pragma unroll
        for (int ai = 0; ai < 2; ++ai)
#pragma unroll
            for (int m = 0; m < 4; ++m) {
                const int row = EPI_ROW(ai, m); asm volatile("" ::: "memory");
                const int pos = row_pos(row);
                const float rstd = rsqrtf(ssq[row] * (1.0f / D) + EPS);
#pragma unroll
                for (int bj = 0; bj < 2; ++bj) {
                    const int cl = bj * 128 + wc * 32 + fq * 8, c = pn * 256 + cl;
                    f32x4 v0 = acc[ai][bj][m][0] * rstd + *(const f32x4*)(bias + c), v1 = acc[ai][bj][m][1] * rstd + *(const f32x4*)(bias + c + 4);
                    const bool isv = (pn == 4 && bj == 1);
                    if (!isv && (cl & 63) < 16) rope8(v0, v1, tabP + pos * 8 + ((cl & 63) >> 1));
                    if (pn < 4) { v0 *= qscale; v1 *= qscale; *(u32x4*)(QS + (size_t)row * 1024 + c) = pack8(v0, v1); }
                    else if (bj == 0) *(u32x4*)(KS + (size_t)row * 128 + cl) = pack8(v0, v1);
                    else *(u32x4*)(VS + (size_t)row * 128 + (cl - 128)) = pack8(v0, v1);
                }
            }
    }
};
#define MFMA32(a, b, c) __builtin_amdgcn_mfma_f32_32x32x16_bf16((a), (b), (c), 0, 0, 0)
typedef short v4i16_t __attribute__((ext_vector_type(4)));
DI s16x4 tr_read(const LAS unsigned char* p) { return __builtin_bit_cast(s16x4, __builtin_amdgcn_ds_read_tr16_b64_v4i16((LAS v4i16_t*)p)); }
DI float xhalf_max(float v) { auto rr = __builtin_amdgcn_permlane32_swap(__float_as_uint(v), __float_as_uint(v), false, false); return fmaxf(__uint_as_float(rr[0]), __uint_as_float(rr[1])); }
DI float xhalf_sum(float v) { auto rr = __builtin_amdgcn_permlane32_swap(__float_as_uint(v), __float_as_uint(v), false, false); return __uint_as_float(rr[0]) + __uint_as_float(rr[1]); }
DI float max3f(float a, float b, float c) { float r; asm("v_max3_f32 %0, %1, %2, %3" : "=v"(r) : "v"(a), "v"(b), "v"(c)); return r; }
DI int crow(int i, int h) { return (i & 3) + 8 * (i >> 2) + 4 * h; }

template <int DQK, int DV, int KP, int VP, bool MASKED, class MaskF>
DI void attn_tile(const LAS unsigned char* Ks, const LAS unsigned char* Vs, const bf16x8 (&qf)[DQK / 16], f32x16 (&o)[DV / 32], float& m, float& l, int lane, const MaskF& allowed) {
    const int r = lane & 31, h = lane >> 5;
    f32x16 s0, s1;
#pragma unroll
    for (int i = 0; i < 16; ++i) { s0[i] = 0.f; s1[i] = 0.f; }
    const LAS unsigned char* kb = Ks + r * KP + h * 16;
    __builtin_amdgcn_s_setprio(1);
#pragma unroll
    for (int ks = 0; ks < DQK / 16; ++ks) {
        if ((ks & 3) == 0 && ks) asm volatile("" ::: "memory");
        const bf16x8 a0 = *(const LAS bf16x8*)(kb + ks * 32);
        const bf16x8 a1 = *(const LAS bf16x8*)(kb + 32 * KP + ks * 32);
        s0 = MFMA32(a0, qf[ks], s0); s1 = MFMA32(a1, qf[ks], s1);
    }
    __builtin_amdgcn_s_setprio(0);
    constexpr bool PFV = (DQK <= 64);
    const int q4 = (lane & 15) >> 2, p4 = lane & 3, blk = (lane >> 4) & 1;
    const LAS unsigned char* vb = Vs + (4 * h + q4) * VP + (16 * blk + 4 * p4) * 2;
    bf16x8 vcur[DV / 32];
    if (PFV) {
#pragma unroll
        for (int dt = 0; dt < DV / 32; ++dt) { const s16x4 lo = tr_read(vb + dt * 64), hi = tr_read(vb + 8 * VP + dt * 64); vcur[dt] = __builtin_shufflevector(lo, hi, 0, 1, 2, 3, 4, 5, 6, 7); }
    }
    asm volatile("" ::: "memory");
    if (MASKED) {
#pragma unroll
        for (int i = 0; i < 16; ++i) { const int k0 = crow(i, h); if (!allowed(k0)) s0[i] = NEGBIG; if (!allowed(32 + k0)) s1[i] = NEGBIG; }
    }
    float mxa = max3f(s0[0], s0[1], s1[0]), mxb = max3f(s0[2], s0[3], s1[1]);
    mxa = max3f(mxa, s1[2], s1[3]);
#pragma unroll
    for (int i = 4; i < 16; i += 4) { mxa = max3f(mxa, s0[i], s0[i + 1]); mxb = max3f(mxb, s0[i + 2], s0[i + 3]); mxa = max3f(mxa, s1[i], s1[i + 1]); mxb = max3f(mxb, s1[i + 2], s1[i + 3]); }
    const float mx = xhalf_max(fmaxf(mxa, mxb));
    const float mn = (mx > m + 8.0f) ? mx : m;
    if (__builtin_amdgcn_ballot_w64(mn != m) != 0ull) {
        const float alpha = __builtin_amdgcn_exp2f(m - mn);
        l *= alpha;
#pragma unroll
        for (int dt = 0; dt < DV / 32; ++dt) o[dt] *= alpha;
        m = mn;
    }
    float ps0 = 0.f, ps1 = 0.f;
#pragma unroll
    for (int i = 0; i < 16; ++i) { s0[i] = __builtin_amdgcn_exp2f(s0[i] - mn); s1[i] = __builtin_amdgcn_exp2f(s1[i] - mn); ps0 += s0[i]; ps1 += s1[i]; }
    l += ps0 + ps1;
    bf16x8 pb[4];
#pragma unroll
    for (int s = 0; s < 2; ++s) {
        u32x4 w0, w1;
        w0.x = pk_bf16(s0[8 * s + 0], s0[8 * s + 1]); w0.y = pk_bf16(s0[8 * s + 2], s0[8 * s + 3]); w0.z = pk_bf16(s0[8 * s + 4], s0[8 * s + 5]); w0.w = pk_bf16(s0[8 * s + 6], s0[8 * s + 7]);
        w1.x = pk_bf16(s1[8 * s + 0], s1[8 * s + 1]); w1.y = pk_bf16(s1[8 * s + 2], s1[8 * s + 3]); w1.z = pk_bf16(s1[8 * s + 4], s1[8 * s + 5]); w1.w = pk_bf16(s1[8 * s + 6], s1[8 * s + 7]);
        pb[s] = __builtin_bit_cast(bf16x8, w0); pb[2 + s] = __builtin_bit_cast(bf16x8, w1);
    }
    __builtin_amdgcn_s_setprio(1);
#pragma unroll
    for (int g = 0; g < 4; ++g) {
        bf16x8 vnext[DV / 32];
        if (PFV) {
            if (g < 3) {
#pragma unroll
                for (int dt = 0; dt < DV / 32; ++dt) { const s16x4 lo = tr_read(vb + (16 * (g + 1)) * VP + dt * 64), hi = tr_read(vb + (16 * (g + 1) + 8) * VP + dt * 64); vnext[dt] = __builtin_shufflevector(lo, hi, 0, 1, 2, 3, 4, 5, 6, 7); }
            }
            asm volatile("" ::: "memory");
        } else {
            asm volatile("" ::: "memory");
#pragma unroll
            for (int dt = 0; dt < DV / 32; ++dt) { const s16x4 lo = tr_read(vb + (16 * g) * VP + dt * 64), hi = tr_read(vb + (16 * g + 8) * VP + dt * 64); vcur[dt] = __builtin_shufflevector(lo, hi, 0, 1, 2, 3, 4, 5, 6, 7); }
        }
#pragma unroll
        for (int dt = 0; dt < DV / 32; ++dt) o[dt] = MFMA32(vcur[dt], pb[g], o[dt]);
        if (PFV && g < 3) {
#pragma unroll
            for (int dt = 0; dt < DV / 32; ++dt) vcur[dt] = vnext[dt];
        }
    }
    __builtin_amdgcn_s_setprio(0);
}

template <int NCH, int N>
DI void tile_load(u32x4 (&reg)[N], const bf16_t* src  , int pitch, int tid) {
#pragma unroll
    for (int i = 0; i < N; ++i) { const int c = tid + 512 * i, key = c / NCH, part = c % NCH; const unsigned off = (unsigned)(key * pitch + part * 8) * 2u;
        reg[i] = *(const u32x4*)((const unsigned char*)src + off); }
}
template <int NCH, int N, int PB>
DI void tile_store(const u32x4 (&reg)[N], LAS unsigned char* buf, int tid) {
#pragma unroll
    for (int i = 0; i < N; ++i) { const int c = tid + 512 * i, key = c / NCH, part = c % NCH; *(LAS u32x4*)(buf + key * PB + part * 16) = reg[i]; }
}

template <int DQK, int DV>
DI void causal_attn(LAS unsigned char* lds, const bf16_t* Qp, int qpitch, const bf16_t* Kp, int kpitch, const bf16_t* Vp, int vpitch, int q0, f32x16 (&o)[DV / 32], int tid) {
    constexpr int KP = DQK * 2 + 16, VP = DV * 2 + 64, KBUF = 64 * KP, VBUF = 64 * VP;
    constexpr int KCH = DQK / 8, VCH = DV / 8, KN = 64 * KCH / 512, VN = 64 * VCH / 512;
    LAS unsigned char* Kb = lds; LAS unsigned char* Vb = lds + 2 * KBUF;
    const int lane = tid & 63, w = tid >> 6, r = lane & 31, h = lane >> 5, qw = q0 + 32 * w;
    const int qtrue = qw + r, qrow = qtrue < 0 ? 0 : (qtrue > LROW - 1 ? LROW - 1 : qtrue);
    bf16x8 qf[DQK / 16];
#pragma unroll
    for (int ks = 0; ks < DQK / 16; ++ks) qf[ks] = *(const bf16x8*)(Qp + (size_t)qrow * qpitch + ks * 16 + h * 8);
    float m = NEGBIG, l = 0.f;
#pragma unroll
    for (int dt = 0; dt < DV / 32; ++dt)
#pragma unroll
        for (int i = 0; i < 16; ++i) o[dt][i] = 0.f;
    const int qlast = (q0 + 255 > LROW - 1) ? LROW - 1 : q0 + 255, ktend = qlast >> 6;
    const bool wactive = (qw + 31 >= NFRONT);
    u32x4 kreg[KN], vreg[VN];
    tile_load<KCH, KN>(kreg, Kp + (size_t)64 * kpitch, kpitch, tid); tile_load<VCH, VN>(vreg, Vp + (size_t)64 * vpitch, vpitch, tid);
    tile_store<KCH, KN, KP>(kreg, Kb, tid); tile_store<VCH, VN, VP>(vreg, Vb, tid);
    __syncthreads();
    int cur = 0;
    for (int kt = 1; kt <= ktend; ++kt) {
        if (kt < ktend) { tile_load<KCH, KN>(kreg, Kp + (size_t)(64 * (kt + 1)) * kpitch, kpitch, tid); tile_load<VCH, VN>(vreg, Vp + (size_t)(64 * (kt + 1)) * vpitch, vpitch, tid); }
        if (wactive && 64 * kt <= qw + 31) {
            const LAS unsigned char* Ks = Kb + cur * KBUF; const LAS unsigned char* Vs = Vb + cur * VBUF;
            const int k64 = 64 * kt;
            auto allowed = [&](int slot) { const int kg = k64 + slot; return kg <= qtrue && kg >= NFRONT; };
            if (k64 + 63 > qw || kt == 1) attn_tile<DQK, DV, KP, VP, true>(Ks, Vs, qf, o, m, l, lane, allowed);
            else attn_tile<DQK, DV, KP, VP, false>(Ks, Vs, qf, o, m, l, lane, allowed);
        }
        if (kt < ktend) { tile_store<KCH, KN, KP>(kreg, Kb + (cur ^ 1) * KBUF, tid); tile_store<VCH, VN, VP>(vreg, Vb + (cur ^ 1) * VBUF, tid); }
        __syncthreads();
        cur ^= 1;
    }
    l = xhalf_sum(l);
    const float inv = 1.0f / l;
#pragma unroll
    for (int dt = 0; dt < DV / 32; ++dt) o[dt] *= inv;
}

template <int NDT>
DI void store_oT(bf16_t* dst, const f32x16 (&o)[NDT], int h, bool zero) {
#pragma unroll
    for (int dt = 0; dt < NDT; ++dt)
#pragma unroll
        for (int g = 0; g < 4; ++g) {
            u32x2 w; w.x = pk_bf16(o[dt][4 * g], o[dt][4 * g + 1]); w.y = pk_bf16(o[dt][4 * g + 2], o[dt][4 * g + 3]);
            if (zero) { w.x = 0u; w.y = 0u; }
            *(u32x2*)(dst + 32 * dt + 8 * g + 4 * h) = w;
        }
}

struct AttnL0 { const bf16_t *QA, *KA, *VA, *QM, *KM, *VM; bf16_t* OAB; gcf subln; float lam; };

DI void attn_unit_diff(LAS unsigned char* lds, const AttnL0& A, int b, int hh, int t, int tid) {
    const int lane = tid & 63, w = tid >> 6, r = lane & 31, h = lane >> 5, q0 = 256 * t - 128, qtrue = q0 + 32 * w + r;
    const size_t rb = (size_t)b * LROW;
    const bf16_t* Vp = A.VA + rb * 512 + hh * 128;
    LAS unsigned* o1s = (LAS unsigned*)(lds + 61440) + tid;
    {
        f32x16 o1[4];
        causal_attn<64, 128>(lds, A.QA + rb * 512 + hh * 128 + 64, 512, A.KA + rb * 512 + hh * 128 + 64, 512, Vp, 512, q0, o1, tid);
#pragma unroll
        for (int dt = 0; dt < 4; ++dt)
#pragma unroll
            for (int i = 0; i < 8; ++i) o1s[(dt * 8 + i) * 512] = pk_bf16(o1[dt][2 * i], o1[dt][2 * i + 1]);
    }
    f32x16 o[4];
    causal_attn<64, 128>(lds, A.QA + rb * 512 + hh * 128, 512, A.KA + rb * 512 + hh * 128, 512, Vp, 512, q0, o, tid);
    float ss = 0.f;
#pragma unroll
    for (int dt = 0; dt < 4; ++dt)
#pragma unroll
        for (int i = 0; i < 8; ++i) {
            const unsigned pw = o1s[(dt * 8 + i) * 512];
            const float x0 = o[dt][2 * i] - A.lam * bf_lo(pw), x1 = o[dt][2 * i + 1] - A.lam * bf_hi(pw);
            o[dt][2 * i] = x0; o[dt][2 * i + 1] = x1; ss += x0 * x0 + x1 * x1;
        }
    ss = xhalf_sum(ss);
    const float rs = rsqrtf(ss * (1.0f / 128) + 1e-5f) * 0.8f;
#pragma unroll
    for (int dt = 0; dt < 4; ++dt)
#pragma unroll
        for (int g = 0; g < 4; ++g) { const f32x4 sg = *(const GAS f32x4*)(A.subln + 32 * dt + 8 * g + 4 * h);
#pragma unroll
            for (int e = 0; e < 4; ++e) o[dt][4 * g + e] *= rs * sg[e]; }
    if (qtrue >= 0 && qtrue < LROW) store_oT<4>(A.OAB + (rb + qtrue) * 1024 + hh * 128, o, h, qtrue < NFRONT);
}
DI void attn_unit_mla(LAS unsigned char* lds, const AttnL0& A, int b, int hh, int t, int tid) {
    const int lane = tid & 63, w = tid >> 6, r = lane & 31, h = lane >> 5, q0 = 256 * t - 128, qtrue = q0 + 32 * w + r;
    const size_t rb = (size_t)b * LROW;
    f32x16 o[4];
    causal_attn<192, 128>(lds, A.QM + rb * 768 + hh * 192, 768, A.KM + rb * 768 + hh * 192, 768, A.VM + rb * 512 + hh * 128, 512, q0, o, tid);
    if (qtrue >= 0 && qtrue < LROW) store_oT<4>(A.OAB + (rb + qtrue) * 1024 + 512 + hh * 128, o, h, qtrue < NFRONT);
}

struct AttnL1 { const bf16_t *QS, *KS, *VS; bf16_t* OS; gcf sinks; };
DI void attn_unit_swa(LAS unsigned char* lds, const AttnL1& A, int b, int kvh, int n, int tid) {
    constexpr int KP = 144, VP = 192, NROW = 320;
    LAS unsigned char* Kb = lds; LAS unsigned char* Vb = lds + NROW * KP;
    const size_t rb = (size_t)b * LROW;
    for (int c = tid; c < NROW * 8; c += 512) {
        const int j = c >> 3, part = c & 7;
        int gr = (j < 256) ? 128 * (n - 1) + j : ((j < 272) ? NFRONT + (j - 256) : -1);
        u32x4 kv = {0u, 0u, 0u, 0u}, vv = {0u, 0u, 0u, 0u};
        if (gr >= 0) { kv = *(const u32x4*)(A.KS + (rb + gr) * 128 + kvh * 64 + part * 8); vv = *(const u32x4*)(A.VS + (rb + gr) * 128 + kvh * 64 + part * 8); }
        *(LAS u32x4*)(Kb + j * KP + part * 16) = kv; *(LAS u32x4*)(Vb + j * VP + part * 16) = vv;
    }
    __syncthreads();
    const int lane = tid & 63, g = tid >> 6, r = lane & 31, h = lane >> 5, head = kvh * 8 + g;
    const float sink = A.sinks[head] * LOG2E;
    for (int j = 0; j < 4; ++j) {
        const int qtrue = 128 * n + 32 * j + r;
        bf16x8 qf[4];
#pragma unroll
        for (int ks = 0; ks < 4; ++ks) qf[ks] = *(const bf16x8*)(A.QS + (rb + qtrue) * 1024 + head * 64 + ks * 16 + h * 8);
        float m = sink, l = (h == 0) ? 1.0f : 0.0f;
        f32x16 o[2];
#pragma unroll
        for (int dt = 0; dt < 2; ++dt)
#pragma unroll
            for (int i = 0; i < 16; ++i) o[dt][i] = 0.f;
        const int tb0 = (j < 2) ? 0 : 1;
        for (int tb = tb0; tb < tb0 + 3; ++tb) {
            const int kbase = 128 * (n - 1) + 64 * tb;
            auto allowed = [&](int slot) { const int kg = kbase + slot; return kg <= qtrue && kg >= NFRONT && (kg < 128 || qtrue - kg < 128); };
            attn_tile<64, 64, KP, VP, true>(Kb + 64 * tb * KP, Vb + 64 * tb * VP, qf, o, m, l, lane, allowed);
        }
        if (n >= 2) {
            auto allowed = [&](int slot) { return slot < 16; };
            attn_tile<64, 64, KP, VP, true>(Kb + 256 * KP, Vb + 256 * VP, qf, o, m, l, lane, allowed);
        }
        l = xhalf_sum(l);
        const float inv = 1.0f / l;
#pragma unroll
        for (int dt = 0; dt < 2; ++dt) o[dt] *= inv;
        store_oT<2>(A.OS + (rb + qtrue) * 1024 + head * 64, o, h, qtrue < NFRONT);
    }
    __syncthreads();
}
#define XB_TMO      128
#define XB_XCNT(j)  (256  + 64 * (j))
#define XB_XSUB(j)  (1280 + 64 * (j))
#define XB_XGEN(j)  (2304 + 64 * (j))
#define XB_TOP      3328
#define XB_TOPGEN   3392
#define XCD_BAR_WORDS 3456
#define XB_SPIN_CAP (1u << 18)

__device__ __forceinline__ unsigned xb_ld(unsigned* p)              { return __hip_atomic_load(p, __ATOMIC_RELAXED, __HIP_MEMORY_SCOPE_AGENT); }
__device__ __forceinline__ unsigned xb_add(unsigned* p, unsigned v) { return __hip_atomic_fetch_add(p, v, __ATOMIC_RELAXED, __HIP_MEMORY_SCOPE_AGENT); }
__device__ __forceinline__ unsigned xb_xcc_id() { return (unsigned)__builtin_amdgcn_s_getreg((3 << 11) | 20) & 0xFu; }
#define XB_SPIN(cond, bar) do { unsigned _sp = 0; while (cond) { __builtin_amdgcn_s_sleep(1); \
    if ((++_sp & 255u) == 0u) { if (xb_ld(&(bar)[XB_TMO])) break; if (_sp > XB_SPIN_CAP) { atomicAdd(&(bar)[XB_TMO], 1u); break; } } } } while (0)

struct XcdBarrier {
    unsigned* bar; unsigned x;
    volatile LAS unsigned* st;
};

__device__ __forceinline__ XcdBarrier xcd_barrier_post(unsigned* bar, volatile LAS unsigned* st) {
    XcdBarrier b; b.bar = bar; b.x = xb_xcc_id(); b.st = st;
    if (threadIdx.x == 0) (void)xb_add(&bar[XB_XCNT(b.x)], 1u);
    return b;
}
__device__ __forceinline__ void xcd_barrier_complete(unsigned* bar, unsigned x, unsigned& nloc, unsigned& nx) {
    const unsigned G = gridDim.x * gridDim.y * gridDim.z;
    unsigned sum, cnt, mine, sp = 0u;
    for (;;) {
        sum = 0u; cnt = 0u; mine = 0u;
#pragma unroll
        for (unsigned j = 0; j < 16; ++j) { const unsigned c = xb_ld(&bar[XB_XCNT(j)]); sum += c; cnt += (c > 0u) ? 1u : 0u; mine = (j == x) ? c : mine; }
        if (sum == G) break;
        __builtin_amdgcn_s_sleep(1);
        if ((++sp & 255u) == 0u) { if (xb_ld(&bar[XB_TMO])) break; if (sp > XB_SPIN_CAP) { atomicAdd(&bar[XB_TMO], 1u); break; } }
    }
    nloc = mine > 0u ? mine : 1u; nx = cnt > 0u ? cnt : 1u;
}

__device__ __forceinline__ void xcd_barrier(const XcdBarrier& b) {
    asm volatile("s_waitcnt vmcnt(0)" ::: "memory");
    __syncthreads();
    if (threadIdx.x == 0) {
        unsigned* bar = b.bar;
        __builtin_amdgcn_s_waitcnt(0);
        unsigned nloc = b.st[0], nx = b.st[1];
        if (nloc == 0u) { xcd_barrier_complete(bar, b.x, nloc, nx); b.st[0] = nloc; b.st[1] = nx; }
        const unsigned old = xb_add(&bar[XB_XSUB(b.x)], 1u);
        const unsigned gen = old / nloc;
        if (old + 1u == (gen + 1u) * nloc) {
            __builtin_amdgcn_fence(__ATOMIC_RELEASE, "agent");
            asm volatile("s_waitcnt vmcnt(0)" ::: "memory");
            const unsigned og = xb_add(&bar[XB_TOP], 1u);
            const unsigned tg = og / nx;
            if (og + 1u == (tg + 1u) * nx) xb_add(&bar[XB_TOPGEN], 1u);
            else XB_SPIN(xb_ld(&bar[XB_TOPGEN]) == tg, bar);
            __builtin_amdgcn_fence(__ATOMIC_ACQUIRE, "agent");
            xb_add(&bar[XB_XGEN(b.x)], 1u);
            asm volatile("s_waitcnt vmcnt(0)" ::: "memory");
        } else {
            XB_SPIN(xb_ld(&bar[XB_XGEN(b.x)]) == gen, bar);
            __builtin_amdgcn_fence(__ATOMIC_ACQUIRE, "agent");
            asm volatile("s_waitcnt vmcnt(0)" ::: "memory");
        }
    }
    __syncthreads();
}

DI int srccol(int kind, int nd) {
    if (kind == 1) return 128 * (nd >> 8) + (nd & 127);
    if (kind == 2) { if (nd < 1024) return (nd & ~63) + permP(nd & 63); if (nd < 2048) return nd; if (nd < 2112) return 2048 + permM(nd - 2048); return -1; }
    if (kind == 3) { const int hh = nd / 192, d = nd % 192; return hh * 192 + (d < 128 ? d : 128 + permM(d - 128)); }
    if (kind == 4) { if (nd < 1152) return (nd & ~63) + permP(nd & 63); return nd; }
    return nd;
}
DI void wt_item(gcf W, int ldw, int nsrc, int Kdim, int k0, int n0, int kind, gcf gain, bf16_t* WT, LAS float* scr, int lane) {
    const int sbase = (kind == 1) ? 128 * (n0 >> 8) : n0;
    const int c4 = (lane & 31) * 4;
    const bool okc = sbase + c4 < nsrc;
    f32x4 v[16];
#pragma unroll
    for (int i = 0; i < 16; ++i) {
        const int kk = 2 * i + (lane >> 5);
        v[i] = (f32x4){0.f, 0.f, 0.f, 0.f};
        if (okc) v[i] = *(const GAS f32x4*)(W + (size_t)(k0 + kk) * ldw + sbase + c4);
    }
#pragma unroll
    for (int i = 0; i < 16; ++i) {
        const int kk = 2 * i + (lane >> 5);
        if (gain) v[i] *= gain[k0 + kk];
        *(LAS f32x4*)(scr + kk * 132 + c4) = v[i];
    }
    asm volatile("s_waitcnt lgkmcnt(0)" ::: "memory");
    const int kq = lane >> 4;
#pragma unroll
    for (int j = 0; j < 8; ++j) {
        const int n = (lane & 15) + 16 * j;
        const int sc = srccol(kind, n0 + n);
        u32x4 o = {0u, 0u, 0u, 0u};
        if (sc >= 0) { const LAS float* s = scr + (8 * kq) * 132 + (sc - sbase);
            o.x = pk_bf16(s[0 * 132], s[1 * 132]); o.y = pk_bf16(s[2 * 132], s[3 * 132]); o.z = pk_bf16(s[4 * 132], s[5 * 132]); o.w = pk_bf16(s[6 * 132], s[7 * 132]); }
        *(u32x4*)(WT + (size_t)(n0 + n) * Kdim + k0 + 8 * kq) = o;
    }
    asm volatile("s_waitcnt lgkmcnt(0)" ::: "memory");
}
constexpr int I_GU = 32 * 44, I_DN = 88 * 8, I_FFN = I_GU + I_DN, I_WIN = 32 * 18, I_UQ = 8 * 6, I_UKV = 8 * 8, I_WO = 32 * 8, I_QKV = 32 * 10;
constexpr int W_ITEMS_L0 = 2 * I_FFN + I_WIN + I_UQ + I_UKV + I_WO, W_ITEMS = W_ITEMS_L0 + 2 * I_FFN + I_QKV + I_WO;
DI void convert_weights(unsigned char* ws, LAS unsigned char* lds, int tid, int it_lo, int it_hi, int gw, int NGW) {
    const int lane = tid & 63, wave = tid >> 6;
    LAS float* scr = (LAS float*)(lds + wave * 16896);
    bf16_t* WB = (bf16_t*)(ws + WS_W);
    for (int it = it_lo + gw; it < it_hi; it += NGW) {
        int r = it, lyr = 0;
        if (r >= W_ITEMS_L0) { r -= W_ITEMS_L0; lyr = 1; }
        if (r < 2 * I_FFN) {
            const int f = r / I_FFN, fi = 2 * lyr + f; r %= I_FFN;
            if (r < I_GU) {
                const int kb = r / 44, n0 = (r % 44) * 128;
                gcf W = (((n0 & 255) < 128) ? (f ? INP(24) : INP(3)) : (f ? INP(25) : INP(4))) + (size_t)lyr * D * FF;
                wt_item(W, FF, FF, D, kb * 32, n0, 1, (f ? INP(23) : INP(2)) + lyr * D, WB + WOFF_FFN + (size_t)fi * (W_GU + W_DN), scr, lane);
            } else {
                r -= I_GU;
                wt_item((f ? INP(26) : INP(5)) + (size_t)lyr * FF * D, D, D, FF, (r / 8) * 32, (r % 8) * 128, 0, nullptr, WB + WOFF_FFN + (size_t)fi * (W_GU + W_DN) + W_GU, scr, lane);
            }
            continue;
        }
        r -= 2 * I_FFN;
        if (lyr == 0) {
            if (r < I_WIN) { wt_item(INP(7), 2112, 2112, D, (r / 18) * 32, (r % 18) * 128, 2, INP(6), WB + WOFF_WIN, scr, lane); continue; } r -= I_WIN;
            if (r < I_UQ) { wt_item(INP(14), 768, 768, 256, (r / 6) * 32, (r % 6) * 128, 3, INP(13), WB + WOFF_UQ, scr, lane); continue; } r -= I_UQ;
            if (r < I_UKV) { wt_item(INP(16), 1024, 1024, 256, (r / 8) * 32, (r % 8) * 128, 0, INP(15), WB + WOFF_UKV, scr, lane); continue; } r -= I_UKV;
            wt_item(INP(17), 1024, 1024, D, (r / 8) * 32, (r % 8) * 128, 0, nullptr, WB + WOFF_WO0, scr, lane);
        } else {
            if (r < I_QKV) { wt_item(INP(18), 1280, 1280, D, (r / 10) * 32, (r % 10) * 128, 4, INP(6) + D, WB + WOFF_QKV, scr, lane); continue; } r -= I_QKV;
            wt_item(INP(21), 1024, 1024, D, (r / 8) * 32, (r % 8) * 128, 0, nullptr, WB + WOFF_WO1, scr, lane);
        }
    }
}

DI void prologue(const Args& a, LAS unsigned char* lds, int tid) {
    const int lane = tid & 63, wave = tid >> 6;
    const int gt = blockIdx.x * 512 + tid, nthr = gridDim.x * 512;
    const int gw = blockIdx.x * 8 + wave, NGW = gridDim.x * 8;
    float* ssq = (float*)(a.ws + WS_SSQ);
    for (int i = gt; i < 8 * R; i += nthr) ssq[R + i] = 0.f;
    if (gt < 256) ((unsigned*)(a.ws + WS_CTL))[gt] = 0u;
    for (int i = gt; i < XCD_BAR_WORDS; i += nthr) ((unsigned*)(a.ws + WS_CTL))[4096 + i] = 0u;
    {
        float2* tabP = (float2*)(a.ws + WS_TABP); float2* tabM = (float2*)(a.ws + WS_TABM);
        for (int e = gt; e < NPOS * 40; e += nthr) {
            const int pos = e / 40, i = e % 40;
            const double ex = (i < 8) ? (double)(2 * i) / 16.0 : (double)(2 * (i - 8)) / 64.0;
            const double inv = exp2(-ex * 18.931568569324174);
            double rev = (double)pos * inv * 0.15915494309189535;
            rev -= floor(rev);
            const float f = (float)rev;
            const float2 cs = make_float2(__builtin_amdgcn_cosf(f), __builtin_amdgcn_sinf(f));
            if (i < 8) tabP[pos * 8 + i] = cs; else tabM[pos * 32 + (i - 8)] = cs;
        }
    }
    { float* bp = (float*)(a.ws + WS_BQKV); gcf bq = INP(19); for (int i = gt; i < NQKV; i += nthr) bp[i] = bq[srccol(4, i)]; }
    {
        float* H = (float*)(a.ws + WS_H); bf16_t* HB = (bf16_t*)(a.ws + WS_HB);
        for (int row = gw; row < R; row += NGW) {
            const int b = row / LROW, i = row % LROW;
            gcf src = (i < NFRONT) ? nullptr : (i < 128 ? INP(1) + (size_t)(i - NFRONT) * D : INP(0) + ((size_t)b * SEQ + (i - 128)) * D);
            float s = 0.f;
#pragma unroll
            for (int j = 0; j < 4; ++j) {
                f32x4 v = {0.f, 0.f, 0.f, 0.f};
                if (src) v = *(const GAS f32x4*)(src + 256 * j + 4 * lane);
                *(f32x4*)(H + (size_t)row * D + 256 * j + 4 * lane) = v;
                u32x2 w; w.x = pk_bf16(v[0], v[1]); w.y = pk_bf16(v[2], v[3]);
                *(u32x2*)(HB + (size_t)row * D + 256 * j + 4 * lane) = w;
                s += (v[0] * v[0] + v[1] * v[1]) + (v[2] * v[2] + v[3] * v[3]);
            }
            s = wave_sum(s);
            if (lane == 0) ssq[row] = s;
        }
    }
    convert_weights(a.ws, lds, tid, 0, W_ITEMS_L0, gw, NGW);
}

constexpr int NPH_ = 17;
__global__ void __launch_bounds__(512, 2) fwd(Args a) {
    extern __shared__ __attribute__((aligned(16))) unsigned char lds_raw[];
    LAS unsigned char* lds = (LAS unsigned char*)lds_raw;
    volatile LAS unsigned* misc = (volatile LAS unsigned*)(lds + LDS_MISC);
    cg::grid_group grid = cg::this_grid();
    volatile LAS unsigned* xst = (volatile LAS unsigned*)(lds + 147392);
    if (threadIdx.x == 0) { xst[0] = 0u; xst[1] = 0u; }
    __syncthreads();
    int tid = threadIdx.x, bid = blockIdx.x;
    unsigned char* ws = a.ws;
#define ssq ((float*)(ws + WS_SSQ))
#define H ((float*)(ws + WS_H))
#define HB ((bf16_t*)(ws + WS_HB))
#define ACT ((bf16_t*)(ws + WS_ACT))
#define WB ((bf16_t*)(ws + WS_W))
#define tabP ((const float2*)(ws + WS_TABP))
#define tabM ((const float2*)(ws + WS_TABM))
#define QA ((bf16_t*)(ws + WS_QA))
#define KA ((bf16_t*)(ws + WS_KA))
#define VA ((bf16_t*)(ws + WS_VA))
#define QM ((bf16_t*)(ws + WS_QM))
#define CQ ((bf16_t*)(ws + WS_CQ))
#define CKV ((bf16_t*)(ws + WS_CKV))
#define KM ((bf16_t*)(ws + WS_KM))
#define OAB ((bf16_t*)((unsigned char*)a.out + OUT_OAB))
#define VM ((bf16_t*)((unsigned char*)a.out + OUT_VM))
#define QS ((bf16_t*)(ws + WS_QS))
#define KS ((bf16_t*)(ws + WS_KS))
#define VS ((bf16_t*)(ws + WS_VS))
#define OS ((bf16_t*)(ws + WS_OS))
    const int lo = a.ph_lo, hi = a.ph_hi;
#define IN(k) (lo <= (k) && (k) < hi)
#define REPS(k)
#define SEAM(k) do { if (IN(k) && IN((k) + 1)) { if ((k) == 0 || !(lo == 0 && hi == NPH_)) grid.sync(); else { XcdBarrier xb_; xb_.bar = (unsigned*)(a.ws + WS_CTL) + 4096; xb_.x = xb_xcc_id(); xb_.st = xst; xcd_barrier(xb_); } } } while (0)
#define RUN_GEMM(EpiT, E, Aptr, Bptr, N_, K_) do { int k_rt = (K_); asm volatile("" : "+s"(k_rt)); pg8::Gemm g{(Aptr), (Bptr), R, (N_), k_rt}; pg8::StaticOrder S; S.init(R, (N_), (int)gridDim.x, bid); \
        pg8::gemm_phase<EpiT, pg8::StaticOrder, true, true>(lds, g, S, (E)); } while (0)

#define LAUNDER_TID() do { tid = threadIdx.x; asm volatile("" : "+v"(tid)); { size_t z_ = 0; asm volatile("" : "+s"(z_)); ws = a.ws + z_; } bid = blockIdx.x; asm volatile("" : "+s"(bid)); } while (0)
    if (IN(0)) { LAUNDER_TID(); REPS(0) { prologue(a, lds, tid); __syncthreads(); } }
    SEAM(0);
    if (lo == 0 && hi == NPH_) (void)xcd_barrier_post((unsigned*)(a.ws + WS_CTL) + 4096, xst);
    int ph = 1;
    for (int l = 0; l < 2; ++l) {
        const bf16_t* Wgu1 = WB + WOFF_FFN + (size_t)(2 * l) * (W_GU + W_DN);
        if (IN(ph)) { LAUNDER_TID(); EpiSwiglu E{ws, 3 * l}; REPS(ph) RUN_GEMM(EpiSwiglu, E, HB, Wgu1, 5632, D); }
        SEAM(ph); ++ph;
        if (IN(ph)) { LAUNDER_TID(); EpiResid E{ws, 3 * l + 1, 0, 0.5f}; RUN_GEMM(EpiResid, E, ACT, Wgu1 + W_GU, D, FF);
            if (l == 0) {
                const int b0 = gridDim.x > 16 ? 8 : 0, nbk = (int)gridDim.x - b0;
                if (bid >= b0) convert_weights(ws, lds, tid, W_ITEMS_L0, W_ITEMS, (bid - b0) * 8 + (tid >> 6), nbk * 8);
            } }
        SEAM(ph); ++ph;
        if (l == 0) {
            if (IN(ph)) { LAUNDER_TID(); EpiWin E{ws, 0.125f * LOG2E}; RUN_GEMM(EpiWin, E, HB, WB + WOFF_WIN, NWIN, D); }
            SEAM(ph); ++ph;
            if (IN(ph)) { LAUNDER_TID();
                REPS(ph) { EpiUq E{ws, 0.07216878364870322f * LOG2E}; RUN_GEMM(EpiUq, E, CQ, WB + WOFF_UQ, NUQ, 256); }
                REPS(ph) { EpiUkv E{ws, (unsigned char*)a.out}; RUN_GEMM(EpiUkv, E, CKV, WB + WOFF_UKV, NUKV, 256); }
            }
            SEAM(ph); ++ph;
            if (IN(ph)) { LAUNDER_TID();
                LAUNDER_TID();
                if (tid < 64) {
                    const float s1 = wave_sum(INP(8)[tid] * INP(9)[tid]), s2 = wave_sum(INP(10)[tid] * INP(11)[tid]);
                    if (tid == 0) misc[1] = __float_as_uint(__expf(s1) - __expf(s2) + 0.2f);
                }
                __syncthreads();
                AttnL0 A{QA, KA, VA, QM, KM, VM, OAB, INP(12), __uint_as_float(misc[1])};
                unsigned* qctr = (unsigned*)(ws + WS_CTL);
                REPS(ph) {
                for (;;) {
                    if (tid == 0) misc[0] = atomicAdd(qctr, 1u);
                    __syncthreads();
                    const unsigned idx = misc[0];
                    __syncthreads();
                    if (idx >= 33u * 16u) break;
                    const int t = 32 - (int)(idx >> 4), rem = idx & 15;
                    attn_unit_diff(lds, A, rem & 3, rem >> 2, t, tid);
                }
                asm volatile("" ::: "memory");
                for (;;) {
                    if (tid == 0) misc[0] = atomicAdd(qctr + 64, 1u);
                    __syncthreads();
                    const unsigned idx = misc[0];
                    __syncthreads();
                    if (idx >= 33u * 16u) break;
                    const int t = 32 - (int)(idx >> 4), rem = idx & 15;
                    attn_unit_mla(lds, A, rem & 3, rem >> 2, t, tid);
                }
                }
            }
            SEAM(ph); ++ph;
            if (IN(ph)) { LAUNDER_TID(); EpiResid E{ws, 2, 0, 1.0f}; RUN_GEMM(EpiResid, E, OAB, WB + WOFF_WO0, D, D); }
            SEAM(ph); ++ph;
        } else {
            if (IN(ph)) { LAUNDER_TID(); EpiQkvS E{ws, 0.125f * LOG2E}; RUN_GEMM(EpiQkvS, E, HB, WB + WOFF_QKV, NQKV, D); }
            SEAM(ph); ++ph;
            if (IN(ph)) { LAUNDER_TID();
                LAUNDER_TID();
                AttnL1 A{QS, KS, VS, OS, INP(20)};
                REPS(ph) for (int u = bid; u < NB * 2 * 65; u += gridDim.x) { const int b = u / 130, rem = u % 130; attn_unit_swa(lds, A, b, rem / 65, rem % 65, tid); }
            }
            SEAM(ph); ++ph;
            if (IN(ph)) { LAUNDER_TID(); EpiResid E{ws, 5, 1, 1.0f}; RUN_GEMM(EpiResid, E, OS, WB + WOFF_WO1, D, D); }
            SEAM(ph); ++ph;
        }
        const bf16_t* Wgu2 = WB + WOFF_FFN + (size_t)(2 * l + 1) * (W_GU + W_DN);
        if (IN(ph)) { LAUNDER_TID(); EpiSwiglu E{ws, 3 * l + 2}; REPS(ph) RUN_GEMM(EpiSwiglu, E, HB, Wgu2, 5632, D); }
        SEAM(ph); ++ph;
        if (IN(ph)) { LAUNDER_TID(); EpiResid E{ws, 3 * l + 3, 0, 0.5f}; RUN_GEMM(EpiResid, E, ACT, Wgu2 + W_GU, D, FF); }
        SEAM(ph); ++ph;
    }
    if (IN(ph)) { LAUNDER_TID();
        LAUNDER_TID();
        const int lane = tid & 63, gw = bid * 8 + (tid >> 6), NGW = gridDim.x * 8;
        gcf gf = INP(27);
        REPS(ph) for (int s = gw; s < NB * SEQ; s += NGW) {
            const int row = (s / SEQ) * LROW + 128 + (s % SEQ);
            const float rstd = rsqrtf(ssq[(size_t)6 * R + row] * (1.0f / D) + EPS);
#pragma unroll
            for (int j = 0; j < 4; ++j) {
                const f32x4 v = *(const f32x4*)(H + (size_t)row * D + 256 * j + 4 * lane), gg = *(const GAS f32x4*)(gf + 256 * j + 4 * lane);
                *(f32x4*)(a.out + (size_t)s * D + 256 * j + 4 * lane) = v * rstd * gg;
            }
        }
    }
}
constexpr int NPH = 17;

extern "C" void kernel_launch(void* const* d_in, const int* in_sizes, int n_in, void* d_out, int out_size, void* d_ws, size_t ws_size, hipStream_t stream) {
    static int grid = 0;
    if (grid == 0) {
        if (n_in != 28 || out_size != NB * SEQ * D || ws_size < WS_END) { fprintf(stderr, "kernel_launch: unexpected problem (n_in %d out %d ws %zu)\n", n_in, out_size, ws_size); grid = -1; return; }
        int dev = 0, cus = 0, per = 0;
        (void)hipGetDevice(&dev); (void)hipDeviceGetAttribute(&cus, hipDeviceAttributeMultiprocessorCount, dev);
        (void)hipFuncSetAttribute((const void*)fwd, hipFuncAttributeMaxDynamicSharedMemorySize, LDS_BYTES);
        (void)hipOccupancyMaxActiveBlocksPerMultiprocessor(&per, (const void*)fwd, 512, LDS_BYTES);
        (void)hipGetLastError();
        grid = cus > 0 ? cus : 256;
    }
    if (grid < 0) return;
    Args a{};
    for (int i = 0; i < 28; ++i) a.in[i] = (const float*)d_in[i];
    a.out = (float*)d_out; a.ws = (unsigned char*)d_ws;
#if MK_PER_PHASE
    for (int p = 0; p < NPH; ++p) {
        const int reps = ((PROBE_MASK >> p) & 1u) ? PROBE_N : 1;
        for (int r = 0; r < reps; ++r) {
            if (p == 5 && r > 0) (void)hipMemsetAsync(d_ws, 0, 1024, stream);
            a.ph_lo = p; a.ph_hi = p + 1; hipLaunchKernelGGL(fwd, dim3(grid), dim3(512), LDS_BYTES, stream, a);
        }
    }
#else
    a.ph_lo = 0; a.ph_hi = NPH;
    void* args[] = {&a};
    hipError_t e = hipLaunchCooperativeKernel((const void*)fwd, dim3(grid), dim3(512), args, LDS_BYTES, stream);
    if (e != hipSuccess) fprintf(stderr, "cooperative launch failed: %s (grid %d)\n", hipGetErrorString(e), grid);
#endif
}
```

```cpp
#include <hip/hip_runtime.h>
#include <hip/hip_cooperative_groups.h>
#include <cstdio>
#include <cstdint>
#include <cmath>
namespace cg = cooperative_groups;
#ifndef MK_PER_PHASE
#define MK_PER_PHASE 0
#endif
#ifndef PROBE_MASK
#define PROBE_MASK 0u
#endif
#ifndef PROBE_N
#define PROBE_N 2
#endif
namespace pg8 {
#define PG8_LAS __attribute__((address_space(3)))
typedef unsigned short bf16_t;
typedef short bf16x8 __attribute__((ext_vector_type(8)));
typedef float f32x4 __attribute__((ext_vector_type(4)));
typedef unsigned u32x4 __attribute__((ext_vector_type(4)));
constexpr int BM = 256, BK = 64, HALF = 128, HTB = HALF * BK * 2  , STAGE_BYTES = 8 * HTB, NXCD = 8, WGM = 8;

__host__ __device__ __forceinline__ int lds_byte(int r, int c) { const int st = (r >> 4) * 2 + (c >> 5), rr = r & 15, cc = c & 31, ob = rr * 64 + cc * 2; return st * 1024 + (ob ^ (((ob >> 9) & 1) << 5)); }
__host__ __device__ __forceinline__ void stage_rc(int b, int& R, int& C) { const int st = b / 1024, sb = b % 1024, swz = sb ^ (((sb >> 9) & 1) << 5); R = (st >> 1) * 16 + swz / 64; C = (st & 1) * 32 + (swz % 64) / 2; }
__host__ __device__ __forceinline__ int perm32(int rho) { const int n = rho >> 4, i = rho & 15; return 8 * (i >> 2) + 4 * n + (i & 3); }

struct Unit { int pm, pn; };
struct Gemm { const bf16_t* A; const bf16_t* Bt; int M, N, K, nt; };

struct StaticOrder {
    int nM, nN, nwg, G, c;
    __host__ __device__ void init(int M, int N, int G_, int c_) { nM = M / BM; nN = N / BM; nwg = nM * nN; G = G_; c = c_; }
    __host__ __device__ bool next(int i, Unit& u) const {
        const long L = (long)i * G + c; if (L >= nwg) return false;
        int wgid = (int)L; { const int q = nwg / NXCD, r = nwg % NXCD, xcd = wgid % NXCD, off = wgid / NXCD; wgid = (xcd < r ? xcd * (q + 1) : r * (q + 1) + (xcd - r) * q) + off; }
        const int nig = WGM * nN, gid = wgid / nig, fm = gid * WGM, gsz = (nM - fm) < WGM ? (nM - fm) : WGM;
        u.pm = fm + ((wgid % nig) % gsz); u.pn = (wgid % nig) / gsz; return true;
    }
    __device__ __forceinline__ void a_ready(const Unit&) const {}
    __device__ __forceinline__ void done(const Unit&) const {}
};
struct CapOrder {
    StaticOrder b; int cap;
    __host__ __device__ void init(int M, int N, int G_, int c_, int cap_) { b.init(M, N, G_, c_); cap = cap_; }
    __host__ __device__ __forceinline__ static void unit_of(const StaticOrder& o, int L, Unit& u) {
        int wgid = L; { const int q = o.nwg / NXCD, r = o.nwg % NXCD, xcd = wgid % NXCD, off = wgid / NXCD; wgid = (xcd < r ? xcd * (q + 1) : r * (q + 1) + (xcd - r) * q) + off; }
        const int nig = WGM * o.nN, gid = wgid / nig, fm = gid * WGM, gsz = (o.nM - fm) < WGM ? (o.nM - fm) : WGM;
        u.pm = fm + ((wgid % nig) % gsz); u.pn = (wgid % nig) / gsz;
    }
    __host__ __device__ __forceinline__ bool next(int i, Unit& u) const { const long L = (long)i * b.G + b.c; if (L >= cap) return false; unit_of(b, (int)L, u); return true; }
    __device__ __forceinline__ void a_ready(const Unit&) const {}
    __device__ __forceinline__ void done(const Unit&) const {}
};
struct OneUnit {
    Unit u;
    __host__ __device__ __forceinline__ bool next(int i, Unit& o) const { if (i != 0) return false; o = u; return true; }
    __device__ __forceinline__ void a_ready(const Unit&) const {}
    __device__ __forceinline__ void done(const Unit&) const {}
};


__device__ __forceinline__ unsigned cvt_pk_bf16(float lo, float hi) { unsigned r; asm volatile("v_cvt_pk_bf16_f32 %0, %1, %2" : "=v"(r) : "v"(lo), "v"(hi)); return r; }
template <class Epi, class Sched, bool ALIGN_EPI = false, bool SP2 = false>
__device__ __forceinline__ void gemm_phase(PG8_LAS unsigned char* lds, const Gemm g, const Sched& S, const Epi& E) {
    int tid_l = threadIdx.x; asm volatile("" : "+v"(tid_l)); const int tid = tid_l, wid = __builtin_amdgcn_readfirstlane(tid >> 6), lane = tid & 63, wr = wid >> 2, wc = wid & 3, fr = lane & 15, fq = lane >> 4;
    const int K = g.K, nt = g.nt > 0 ? g.nt : K / BK;
    unsigned voffA[2], voffB[2];
#pragma unroll
    for (int i = 0; i < 2; ++i) { int R, C; stage_rc(tid * 16 + i * 8192, R, C); const int Rb = Epi::PERM ? ((R & ~31) + perm32(R & 31)) : R;
        voffA[i] = (unsigned)(R * K + C) * 2u; voffB[i] = (unsigned)(Rb * K + C) * 2u; }
    const size_t kstep = (size_t)(BK * 2);
    const size_t hstep = (size_t)HALF * K * 2;
    const size_t tstep = 2 * hstep;
    const unsigned ldsw = (unsigned)wid * 1024u;
    const int aoff = lds_byte(wr * 64 + fr, fq * 8), boff = lds_byte(wc * 32 + fr, fq * 8);
#define PG8_SA(b, h) (((b) * 2 + (h)) * HTB)
#define PG8_SB(b, h) ((4 + (b) * 2 + (h)) * HTB)
#define PG8_STAGE(bufoff, gbase, voff) do { _Pragma("unroll") for (int _i = 0; _i < 2; ++_i) \
        __builtin_amdgcn_global_load_lds((const unsigned*)((const char*)(gbase) + (voff)[_i]), (PG8_LAS unsigned*)(lds + (bufoff) + ldsw + _i * 8192), 16, 0, 0); } while (0)
#define PG8_LDA(dst, b, h) do { _Pragma("unroll") for (int m = 0; m < 4; ++m) _Pragma("unroll") for (int k = 0; k < 2; ++k) dst[m][k] = *(const PG8_LAS bf16x8*)(lds + PG8_SA(b, h) + aoff + m * 2048 + k * 1024); } while (0)
#define PG8_LDB(dst, b, h) do { _Pragma("unroll") for (int n = 0; n < 2; ++n) _Pragma("unroll") for (int k = 0; k < 2; ++k) dst[n][k] = *(const PG8_LAS bf16x8*)(lds + PG8_SB(b, h) + boff + n * 2048 + k * 1024); } while (0)
#define PG8_MMA(ai, bj, At, Bt) do { __builtin_amdgcn_s_setprio(1); _Pragma("unroll") for (int m = 0; m < 4; ++m) _Pragma("unroll") for (int n = 0; n < 2; ++n) _Pragma("unroll") for (int k = 0; k < 2; ++k) \
        acc[ai][bj][m][n] = __builtin_amdgcn_mfma_f32_16x16x32_bf16(Bt[n][k], At[m][k], acc[ai][bj][m][n], 0, 0, 0); __builtin_amdgcn_s_setprio(0); } while (0)
#define PG8_WAIT_V(n) asm volatile("s_waitcnt vmcnt(" #n ")" ::: "memory")
#define PG8_WAIT_L(n) asm volatile("s_waitcnt lgkmcnt(" #n ")" ::: "memory")
#define PG8_BAR __builtin_amdgcn_s_barrier()
#define PG8_SCHED __builtin_amdgcn_sched_barrier(0)
    Unit cur, nxt; int ui = 0;
    if (!S.next(0, cur)) return;
    f32x4 acc[2][2][4][2];
#pragma unroll
    for (int a = 0; a < 2; ++a)
#pragma unroll
        for (int b = 0; b < 2; ++b)
#pragma unroll
            for (int m = 0; m < 4; ++m)
#pragma unroll
                for (int n = 0; n < 2; ++n) acc[a][b][m][n] = (f32x4){0.f, 0.f, 0.f, 0.f};
    bf16x8 At[4][2], B0[2][2], B1[2][2];
    const char* cA = (const char*)g.A + (size_t)cur.pm * tstep; const char* cB = (const char*)g.Bt + (size_t)cur.pn * tstep;
    S.a_ready(cur);
    if constexpr (SP2) {
        PG8_STAGE(PG8_SB(0, 0), cB, voffB); PG8_STAGE(PG8_SB(0, 1), cB + hstep, voffB); PG8_STAGE(PG8_SA(0, 0), cA, voffA); PG8_STAGE(PG8_SA(0, 1), cA + hstep, voffA);
        if (wr == 1) PG8_BAR;
        PG8_WAIT_V(2); PG8_BAR;
        PG8_STAGE(PG8_SB(1, 0), cB + kstep, voffB); PG8_STAGE(PG8_SA(1, 0), cA + kstep, voffA); PG8_STAGE(PG8_SB(1, 1), cB + hstep + kstep, voffB);
        PG8_WAIT_V(6); PG8_BAR;
    } else {
        PG8_STAGE(PG8_SB(0, 0), cB, voffB); PG8_STAGE(PG8_SA(0, 0), cA, voffA); PG8_STAGE(PG8_SB(0, 1), cB + hstep, voffB); PG8_STAGE(PG8_SA(0, 1), cA + hstep, voffA);
        if (wr == 1) PG8_BAR;
        PG8_WAIT_V(4); PG8_BAR;
        PG8_STAGE(PG8_SB(1, 0), cB + kstep, voffB); PG8_STAGE(PG8_SA(1, 0), cA + kstep, voffA); PG8_STAGE(PG8_SB(1, 1), cB + hstep + kstep, voffB);
        PG8_WAIT_V(6); PG8_BAR;
    }
    for (;;) {
        const bool has_next = S.next(ui + 1, nxt);
        const char* nA = has_next ? (const char*)g.A + (size_t)nxt.pm * tstep : cA; const char* nB = has_next ? (const char*)g.Bt + (size_t)nxt.pn * tstep : cB;
        for (int t = 0; t < nt; t += 2) {
            const bool last = (t == nt - 2);
            const char* a1 = cA + (size_t)(t + 1) * kstep;
            const char* a2 = last ? nA : cA + (size_t)(t + 2) * kstep; const char* b2 = last ? nB : cB + (size_t)(t + 2) * kstep;
            const char* a3 = a2 + kstep; const char* b3 = b2 + kstep;
            if (last && has_next) S.a_ready(nxt);
            if constexpr (SP2) {
            PG8_LDB(B0, 0, 0); PG8_LDB(B1, 0, 1); PG8_SCHED; PG8_LDA(At, 0, 0); PG8_STAGE(PG8_SA(1, 1), a1 + hstep, voffA);
            PG8_WAIT_V(8); PG8_WAIT_L(0); PG8_BAR; PG8_MMA(0, 0, At, B0); PG8_MMA(0, 1, At, B1); PG8_BAR; PG8_SCHED;
            PG8_LDA(At, 0, 1); PG8_STAGE(PG8_SB(0, 0), b2, voffB); PG8_STAGE(PG8_SB(0, 1), b2 + hstep, voffB); PG8_STAGE(PG8_SA(0, 0), a2, voffA);
            PG8_WAIT_V(8); PG8_WAIT_L(0); PG8_BAR; PG8_MMA(1, 0, At, B0); PG8_MMA(1, 1, At, B1); PG8_BAR; PG8_SCHED;
            PG8_LDB(B0, 1, 0); PG8_LDB(B1, 1, 1); PG8_SCHED; PG8_LDA(At, 1, 0); PG8_STAGE(PG8_SA(0, 1), a2 + hstep, voffA);
            PG8_WAIT_V(8); PG8_WAIT_L(0); PG8_BAR; PG8_MMA(0, 0, At, B0); PG8_MMA(0, 1, At, B1); PG8_BAR; PG8_SCHED;
            PG8_LDA(At, 1, 1); PG8_STAGE(PG8_SB(1, 0), b3, voffB); PG8_STAGE(PG8_SB(1, 1), b3 + hstep, voffB); PG8_STAGE(PG8_SA(1, 0), a3, voffA);
            PG8_WAIT_V(8); PG8_WAIT_L(0); PG8_BAR; PG8_MMA(1, 0, At, B0); PG8_MMA(1, 1, At, B1); PG8_BAR; PG8_SCHED;
            } else {
            PG8_LDB(B0, 0, 0); PG8_SCHED; PG8_LDA(At, 0, 0); PG8_STAGE(PG8_SA(1, 1), a1 + hstep, voffA);
            PG8_WAIT_L(8); PG8_BAR; PG8_WAIT_L(0); PG8_MMA(0, 0, At, B0); PG8_BAR; PG8_SCHED;
            PG8_LDB(B1, 0, 1); PG8_STAGE(PG8_SB(0, 0), b2, voffB);
            PG8_BAR; PG8_WAIT_L(0); PG8_MMA(0, 1, At, B1); PG8_BAR;
            PG8_LDA(At, 0, 1); PG8_STAGE(PG8_SA(0, 0), a2, voffA);
            PG8_BAR; PG8_WAIT_L(0); PG8_MMA(1, 0, At, B0); PG8_BAR; PG8_SCHED;
            PG8_STAGE(PG8_SB(0, 1), b2 + hstep, voffB);
            PG8_WAIT_V(6); PG8_BAR; PG8_MMA(1, 1, At, B1); PG8_BAR;
            PG8_LDB(B0, 1, 0); PG8_SCHED; PG8_LDA(At, 1, 0); PG8_STAGE(PG8_SA(0, 1), a2 + hstep, voffA);
            PG8_WAIT_L(8); PG8_BAR; PG8_WAIT_L(0); PG8_MMA(0, 0, At, B0); PG8_BAR; PG8_SCHED;
            PG8_LDB(B1, 1, 1); PG8_STAGE(PG8_SB(1, 0), b3, voffB);
            PG8_BAR; PG8_WAIT_L(0); PG8_MMA(0, 1, At, B1); PG8_BAR;
            PG8_LDA(At, 1, 1); PG8_STAGE(PG8_SA(1, 0), a3, voffA);
            PG8_BAR; PG8_WAIT_L(0); PG8_MMA(1, 0, At, B0); PG8_BAR; PG8_SCHED;
            PG8_STAGE(PG8_SB(1, 1), b3 + hstep, voffB);
            PG8_WAIT_V(6); PG8_BAR; PG8_MMA(1, 1, At, B1); PG8_BAR;
            }
        }
        if constexpr (ALIGN_EPI) { if (wr == 0) PG8_BAR; }
        if constexpr (!Epi::AFTER_DRAIN) { E(acc, cur, wr, wc, fr, fq); S.done(cur); }
        if (!has_next) break;
#pragma unroll
        for (int a = 0; a < 2; ++a)
#pragma unroll
            for (int b = 0; b < 2; ++b)
#pragma unroll
                for (int m = 0; m < 4; ++m)
#pragma unroll
                    for (int n = 0; n < 2; ++n) acc[a][b][m][n] = (f32x4){0.f, 0.f, 0.f, 0.f};
        cur = nxt; cA = nA; cB = nB; ++ui;
        if constexpr (ALIGN_EPI) { if (wr == 1) PG8_BAR; }
    }
    PG8_WAIT_V(0);
    if constexpr (!ALIGN_EPI) { if (wr == 0) PG8_BAR; }
    PG8_BAR;
    if constexpr (Epi::AFTER_DRAIN) { E.fused(acc, cur, wr, wc, fr, fq, lds, wid, lane); S.done(cur); }
#undef PG8_SA
#undef PG8_SB
#undef PG8_STAGE
#undef PG8_LDA
#undef PG8_LDB
#undef PG8_MMA
#undef PG8_WAIT_V
#undef PG8_WAIT_L
#undef PG8_BAR
#undef PG8_SCHED
}
}
#define LAS __attribute__((address_space(3)))
#define DI __device__ __forceinline__
typedef unsigned short bf16_t;
typedef short bf16x8 __attribute__((ext_vector_type(8)));
typedef short s16x4 __attribute__((ext_vector_type(4)));
typedef float f32x4 __attribute__((ext_vector_type(4)));
typedef float f32x16 __attribute__((ext_vector_type(16)));
typedef unsigned u32x4 __attribute__((ext_vector_type(4)));
typedef unsigned u32x2 __attribute__((ext_vector_type(2)));
typedef float f32x2_t __attribute__((ext_vector_type(2)));
typedef __bf16 bf16x2_t __attribute__((ext_vector_type(2)));

constexpr int NB = 4, SEQ = 8192, LROW = 8320, R = NB * LROW, D = 1024, FF = 2816, NFRONT = 112, NPOS = 8208;
constexpr int NWIN = 2304, NUQ = 768, NUKV = 1024, NQKV = 1280;
constexpr float LOG2E = 1.4426950408889634f;
constexpr float NEGBIG = -1e30f;
constexpr float EPS = 1e-6f;

constexpr size_t MiB = 1u << 20;
constexpr size_t WS_CTL = 0;
constexpr size_t WS_SSQ = 1 * MiB;
constexpr size_t WS_TABP = 3 * MiB;
constexpr size_t WS_TABM = WS_TABP + 768 * 1024;
constexpr size_t WS_W = 6 * MiB;
constexpr size_t W_GU = (size_t)5632 * 1024, W_DN = (size_t)1024 * 2816;
constexpr size_t WOFF_FFN = 0;
constexpr size_t WOFF_WIN = 4 * (W_GU + W_DN);
constexpr size_t WOFF_UQ = WOFF_WIN + (size_t)NWIN * 1024;
constexpr size_t WOFF_UKV = WOFF_UQ + (size_t)NUQ * 256;
constexpr size_t WOFF_WO0 = WOFF_UKV + (size_t)NUKV * 256;
constexpr size_t WOFF_QKV = WOFF_WO0 + (size_t)1024 * 1024;
constexpr size_t WOFF_WO1 = WOFF_QKV + (size_t)NQKV * 1024;
constexpr size_t W_TOTAL = WOFF_WO1 + (size_t)1024 * 1024;
constexpr size_t WS_BQKV = WS_W + 80 * MiB;
static_assert(W_TOTAL * 2 <= 79 * MiB, "weights fit");
constexpr size_t WS_H = 87 * MiB;
constexpr size_t WS_HB = WS_H + (size_t)R * D * 4;
constexpr size_t WS_ACT = WS_HB + (size_t)R * D * 2;
constexpr size_t SZ512 = (size_t)R * 512 * 2, SZ768 = (size_t)R * 768 * 2, SZ256 = (size_t)R * 256 * 2;
constexpr size_t WS_QA = WS_ACT, WS_KA = WS_QA + SZ512, WS_VA = WS_KA + SZ512, WS_QM = WS_VA + SZ512, WS_CQ = WS_QM + SZ768, WS_CKV = WS_CQ + SZ256;
static_assert(WS_CKV + SZ256 <= WS_ACT + (size_t)R * FF * 2, "layer-0 attention inputs overlay act");
constexpr size_t WS_KM = WS_ACT + (size_t)R * FF * 2;
constexpr size_t WS_END = WS_KM + SZ768;
static_assert(WS_END <= 512 * MiB, "d_ws map fits 512 MiB");
constexpr size_t WS_QS = WS_ACT, WS_KS = WS_QS + (size_t)R * 1024 * 2, WS_VS = WS_KS + (size_t)R * 128 * 2, WS_OS = WS_VS + (size_t)R * 128 * 2;
static_assert(WS_OS + (size_t)R * 1024 * 2 <= WS_KM, "layer-1 attention buffers overlay act");
constexpr size_t OUT_OAB = 0, OUT_VM = (size_t)R * 1024 * 2;
constexpr size_t OUT_SPLIT = 98 * MiB;
static_assert(OUT_VM + SZ512 <= OUT_SPLIT && OUT_SPLIT + (size_t)8 * 11 * 65536 * 4 <= (size_t)NB * SEQ * D * 4, "d_out scratch");

constexpr int LDS_BYTES = 147456, LDS_MISC = 131072;

struct Args {
    const float* in[28]; float* out; unsigned char* ws; int ph_lo, ph_hi;
};

#define GAS __attribute__((address_space(1)))
typedef const GAS float* gcf;
DI gcf INP(int i) { asm volatile("" : "+s"(i)); return ((const gcf*)__builtin_amdgcn_kernarg_segment_ptr())[i]; }
DI unsigned pk_bf16(float lo, float hi) { f32x2_t v = {lo, hi}; bf16x2_t b = __builtin_convertvector(v, bf16x2_t); return __builtin_bit_cast(unsigned, b); }
DI float bf_lo(unsigned u) { return __uint_as_float(u << 16); }
DI float bf_hi(unsigned u) { return __uint_as_float(u & 0xffff0000u); }
DI int row_pos(int row) { const int i = row % LROW; return i > NFRONT ? i - NFRONT : 0; }
DI int permP(int d) { return d < 16 ? ((d & 1) ? (d >> 1) + 8 : (d >> 1)) : d; }
DI int permM(int d) { return (d & 1) ? (d >> 1) + 32 : (d >> 1); }
DI float wave_sum(float v) {
#pragma unroll
    for (int o = 1; o < 64; o <<= 1) v += __shfl_xor(v, o);
    return v;
}
DI void rope8(f32x4& v0, f32x4& v1, const float2* tab) {
    const float2 t0 = tab[0], t1 = tab[1], t2 = tab[2], t3 = tab[3];
    f32x4 a = v0, b = v1;
    v0[0] = a[0] * t0.x - a[1] * t0.y; v0[1] = a[1] * t0.x + a[0] * t0.y;
    v0[2] = a[2] * t1.x - a[3] * t1.y; v0[3] = a[3] * t1.x + a[2] * t1.y;
    v1[0] = b[0] * t2.x - b[1] * t2.y; v1[1] = b[1] * t2.x + b[0] * t2.y;
    v1[2] = b[2] * t3.x - b[3] * t3.y; v1[3] = b[3] * t3.x + b[2] * t3.y;
}
DI u32x4 pack8(const f32x4& a, const f32x4& b) { u32x4 w; w.x = pk_bf16(a[0], a[1]); w.y = pk_bf16(a[2], a[3]); w.z = pk_bf16(b[0], b[1]); w.w = pk_bf16(b[2], b[3]); return w; }

#define EPI_ROW(ai, m) (u.pm * 256 + (ai) * 128 + wr * 64 + (m) * 16 + fr)
typedef const f32x4 (&AccRef)[2][2][4][2];

struct EpiSwiglu {
    static constexpr bool PERM = true, AFTER_DRAIN = false;
    unsigned char* ws; int ssq_idx;
    DI void operator()(AccRef acc, const pg8::Unit& u, int wr, int wc, int fr, int fq) const {
        bf16_t* O = (bf16_t*)(ws + WS_ACT); const float* ssq = (const float*)(ws + WS_SSQ) + (size_t)ssq_idx * R;
        const int f0 = u.pn * 128 + wc * 32 + fq * 8;
#pragma unroll
        for (int ai = 0; ai < 2; ++ai)
#pragma unroll
            for (int m = 0; m < 4; ++m) {
                const int row = EPI_ROW(ai, m); asm volatile("" ::: "memory");
                const float rstd = rsqrtf(ssq[row] * (1.0f / D) + EPS);
                f32x4 o[2];
#pragma unroll
                for (int n = 0; n < 2; ++n) {
                    const f32x4 g = acc[ai][0][m][n] * rstd, up = acc[ai][1][m][n] * rstd;
#pragma unroll
                    for (int e = 0; e < 4; ++e) o[n][e] = g[e] * __builtin_amdgcn_rcpf(1.0f + __builtin_amdgcn_exp2f(-g[e] * LOG2E)) * up[e];
                }
                *(u32x4*)(O + (size_t)row * FF + f0) = pack8(o[0], o[1]);
            }
    }
};

struct EpiResid {
    static constexpr bool PERM = true, AFTER_DRAIN = false;
    unsigned char* ws; int ssq_idx; int has_bias; float alpha;
    DI void operator()(AccRef acc, const pg8::Unit& u, int wr, int wc, int fr, int fq) const {
        float* h = (float*)(ws + WS_H); bf16_t* hb = (bf16_t*)(ws + WS_HB); float* ssq_out = (float*)(ws + WS_SSQ) + (size_t)ssq_idx * R; gcf bias = has_bias ? INP(22) : nullptr;
#pragma unroll
        for (int ai = 0; ai < 2; ++ai)
#pragma unroll
            for (int m = 0; m < 4; ++m) {
                const int row = EPI_ROW(ai, m); if (m == 0) asm volatile("" ::: "memory");
                float ss = 0.f;
#pragma unroll
                for (int bj = 0; bj < 2; ++bj) {
                    const int c = u.pn * 256 + bj * 128 + wc * 32 + fq * 8;
                    float* hp = h + (size_t)row * D + c;
                    f32x4 h0 = __builtin_nontemporal_load((const f32x4*)hp), h1 = __builtin_nontemporal_load((const f32x4*)(hp + 4));
                    h0 += acc[ai][bj][m][0] * alpha; h1 += acc[ai][bj][m][1] * alpha;
                    if (bias) { h0 += *(const GAS f32x4*)(bias + c); h1 += *(const GAS f32x4*)(bias + c + 4); }
                    __builtin_nontemporal_store(h0, (f32x4*)hp); __builtin_nontemporal_store(h1, (f32x4*)(hp + 4));
                    *(u32x4*)(hb + (size_t)row * D + c) = pack8(h0, h1);
                    ss += (h0[0] * h0[0] + h0[1] * h0[1]) + (h0[2] * h0[2] + h0[3] * h0[3]) + (h1[0] * h1[0] + h1[1] * h1[1]) + (h1[2] * h1[2] + h1[3] * h1[3]);
                }
                ss += __shfl_xor(ss, 16); ss += __shfl_xor(ss, 32);
                if (fq == 0) atomicAdd(ssq_out + row, ss);
            }
    }
};

struct EpiPartial {
    static constexpr bool PERM = true, AFTER_DRAIN = false;
    unsigned char* outb; int e, sl;
    DI void operator()(AccRef acc, const pg8::Unit& u, int wr, int wc, int fr, int fq) const {
        float* sp = (float*)(outb + OUT_SPLIT) + ((size_t)e * 11 + sl) * 65536;
#pragma unroll
        for (int ai = 0; ai < 2; ++ai)
#pragma unroll
            for (int m = 0; m < 4; ++m) {
                const int rl = ai * 128 + wr * 64 + m * 16 + fr;
#pragma unroll
                for (int bj = 0; bj < 2; ++bj) {
                    float* p = sp + rl * 256 + bj * 128 + wc * 32 + fq * 8;
                    *(f32x4*)p = acc[ai][bj][m][0]; *(f32x4*)(p + 4) = acc[ai][bj][m][1];
                }
            }
    }
};

struct EpiWin {
    static constexpr bool PERM = true, AFTER_DRAIN = false;
    unsigned char* ws; float qscale;
    DI void operator()(AccRef acc, const pg8::Unit& u, int wr, int wc, int fr, int fq) const {
        const float* ssq = (const float*)(ws + WS_SSQ) + (size_t)1 * R; float* ssq_cq = (float*)(ws + WS_SSQ) + (size_t)7 * R; float* ssq_ckv = (float*)(ws + WS_SSQ) + (size_t)8 * R;
        bf16_t *QA = (bf16_t*)(ws + WS_QA), *KA = (bf16_t*)(ws + WS_KA), *VA = (bf16_t*)(ws + WS_VA), *CQ = (bf16_t*)(ws + WS_CQ), *CKV = (bf16_t*)(ws + WS_CKV), *KM = (bf16_t*)(ws + WS_KM);
        const float2* tabP = (const float2*)(ws + WS_TABP); const float2* tabM = (const float2*)(ws + WS_TABM);
        const int pn = u.pn;
#pragma unroll
        for (int ai = 0; ai < 2; ++ai)
#pragma unroll
            for (int m = 0; m < 4; ++m) {
                const int row = EPI_ROW(ai, m); asm volatile("" ::: "memory");
                const int pos = row_pos(row);
                const float rstd = rsqrtf(ssq[row] * (1.0f / D) + EPS);
                float ss = 0.f;
#pragma unroll
                for (int bj = 0; bj < 2; ++bj) {
                    const int cl = bj * 128 + wc * 32 + fq * 8;
                    f32x4 v0 = acc[ai][bj][m][0] * rstd, v1 = acc[ai][bj][m][1] * rstd;
                    if (pn < 4) {
                        if ((cl & 63) < 16) rope8(v0, v1, tabP + pos * 8 + ((cl & 63) >> 1));
                        if (pn < 2) { v0 *= qscale; v1 *= qscale; }
                        bf16_t* dst = (pn < 2 ? QA : KA) + (size_t)row * 512 + (pn & 1) * 256 + cl;
                        *(u32x4*)dst = pack8(v0, v1);
                    } else if (pn < 6) {
                        *(u32x4*)(VA + (size_t)row * 512 + (pn - 4) * 256 + cl) = pack8(v0, v1);
                    } else if (pn < 8) {
                        *(u32x4*)((pn == 6 ? CQ : CKV) + (size_t)row * 256 + cl) = pack8(v0, v1);
                        ss += (v0[0] * v0[0] + v0[1] * v0[1]) + (v0[2] * v0[2] + v0[3] * v0[3]) + (v1[0] * v1[0] + v1[1] * v1[1]) + (v1[2] * v1[2] + v1[3] * v1[3]);
                    } else if (cl < 64) {
                        rope8(v0, v1, tabM + pos * 32 + (cl >> 1));
                        const u32x4 w = pack8(v0, v1);
#pragma unroll
                        for (int hh = 0; hh < 4; ++hh) *(u32x4*)(KM + (size_t)row * 768 + hh * 192 + 128 + cl) = w;
                    }
                }
                if (pn == 6 || pn == 7) {
                    ss += __shfl_xor(ss, 16); ss += __shfl_xor(ss, 32);
                    if (fq == 0) atomicAdd((pn == 6 ? ssq_cq : ssq_ckv) + row, ss);
                }
            }
    }
};

struct EpiUq {
    static constexpr bool PERM = true, AFTER_DRAIN = false;
    unsigned char* ws; float qscale;
    DI void operator()(AccRef acc, const pg8::Unit& u, int wr, int wc, int fr, int fq) const {
        const float* ssq_cq = (const float*)(ws + WS_SSQ) + (size_t)7 * R; bf16_t* QM = (bf16_t*)(ws + WS_QM); const float2* tabM = (const float2*)(ws + WS_TABM);
#pragma unroll
        for (int ai = 0; ai < 2; ++ai)
#pragma unroll
            for (int m = 0; m < 4; ++m) {
                const int row = EPI_ROW(ai, m); asm volatile("" ::: "memory");
                const int pos = row_pos(row);
                const float rstd = rsqrtf(ssq_cq[row] * (1.0f / 256) + EPS);
#pragma unroll
                for (int bj = 0; bj < 2; ++bj) {
                    const int c = u.pn * 256 + bj * 128 + wc * 32 + fq * 8;
                    const int d = c % 192;
                    f32x4 v0 = acc[ai][bj][m][0] * rstd, v1 = acc[ai][bj][m][1] * rstd;
                    if (d >= 128) rope8(v0, v1, tabM + pos * 32 + ((d - 128) >> 1));
                    v0 *= qscale; v1 *= qscale;
                    *(u32x4*)(QM + (size_t)row * 768 + c) = pack8(v0, v1);
                }
            }
    }
};

struct EpiUkv {
    static constexpr bool PERM = true, AFTER_DRAIN = false;
    unsigned char* ws; unsigned char* outb;
    DI void operator()(AccRef acc, const pg8::Unit& u, int wr, int wc, int fr, int fq) const {
        const float* ssq_ckv = (const float*)(ws + WS_SSQ) + (size_t)8 * R; bf16_t* KM = (bf16_t*)(ws + WS_KM); bf16_t* VM = (bf16_t*)(outb + OUT_VM);
#pragma unroll
        for (int ai = 0; ai < 2; ++ai)
#pragma unroll
            for (int m = 0; m < 4; ++m) {
                const int row = EPI_ROW(ai, m); asm volatile("" ::: "memory");
                const float rstd = rsqrtf(ssq_ckv[row] * (1.0f / 256) + EPS);
                const int cl = wc * 32 + fq * 8;
                *(u32x4*)(KM + (size_t)row * 768 + u.pn * 192 + cl) = pack8(acc[ai][0][m][0] * rstd, acc[ai][0][m][1] * rstd);
                *(u32x4*)(VM + (size_t)row * 512 + u.pn * 128 + cl) = pack8(acc[ai][1][m][0] * rstd, acc[ai][1][m][1] * rstd);
            }
    }
};

struct EpiQkvS {
    static constexpr bool PERM = true, AFTER_DRAIN = false;
    unsigned char* ws; float qscale;
    DI void operator()(AccRef acc, const pg8::Unit& u, int wr, int wc, int fr, int fq) const {
        const float* ssq = (const float*)(ws + WS_SSQ) + (size_t)4 * R; const float* bias = (const float*)(ws + WS_BQKV); bf16_t *QS = (bf16_t*)(ws + WS_QS), *KS = (bf16_t*)(ws + WS_KS), *VS = (bf16_t*)(ws + WS_VS); const float2* tabP = (const float2*)(ws + WS_TABP);
        const int pn = u.pn;
#pragma unroll
        for (int ai = 0; ai < 2; ++ai)
#pragma unroll
            for (int m = 0; m < 4; ++m) {
                const int row = EPI_ROW(ai, m); asm volatile("" ::: "memory");
                const int pos = row_pos(row);
                const float rstd = rsqrtf(ssq[row] * (1.0f / D) + EPS);
#pragma unroll
                for (int bj = 0; bj < 2; ++bj) {
                    const int cl = bj * 128 + wc * 32 + fq * 8, c = pn * 256 + cl;
                    f32x4 v0 = acc[ai][bj][m][0] * rstd + *(const f32x4*)(bias + c), v1 = acc[ai][bj][m][1] * rstd + *(const f32x4*)(bias + c + 4);
                    const bool isv = (pn == 4 && bj == 1);
                    if (!isv && (cl & 63) < 16) rope8(v0, v1, tabP + pos * 8 + ((cl & 63) >> 1));
                    if (pn < 4) { v0 *= qscale; v1 *= qscale; *(u32x4*)(QS + (size_t)row * 1024 + c) = pack8(v0, v1); }
                    else if (bj == 0) *(u32x4*)(KS + (size_t)row * 128 + cl) = pack8(v0, v1);
                    else *(u32x4*)(VS + (size_t)row * 128 + (cl - 128)) = pack8(v0, v1);
                }
            }
    }
};
#define MFMA32(a, b, c) __builtin_amdgcn_mfma_f32_32x32x16_bf16((a), (b), (c), 0, 0, 0)
typedef short v4i16_t __attribute__((ext_vector_type(4)));
DI s16x4 tr_read(const LAS unsigned char* p) { return __builtin_bit_cast(s16x4, __builtin_amdgcn_ds_read_tr16_b64_v4i16((LAS v4i16_t*)p)); }
DI float xhalf_max(float v) { auto rr = __builtin_amdgcn_permlane32_swap(__float_as_uint(v), __float_as_uint(v), false, false); return fmaxf(__uint_as_float(rr[0]), __uint_as_float(rr[1])); }
DI float xhalf_sum(float v) { auto rr = __builtin_amdgcn_permlane32_swap(__float_as_uint(v), __float_as_uint(v), false, false); return __uint_as_float(rr[0]) + __uint_as_float(rr[1]); }
DI float max3f(float a, float b, float c) { float r; asm("v_max3_f32 %0, %1, %2, %3" : "=v"(r) : "v"(a), "v"(b), "v"(c)); return r; }
DI int crow(int i, int h) { return (i & 3) + 8 * (i >> 2) + 4 * h; }

template <int DQK, int DV, int KP, int VP, bool MASKED, class MaskF>
DI void attn_tile(const LAS unsigned char* Ks, const LAS unsigned char* Vs, const bf16x8 (&qf)[DQK / 16], f32x16 (&o)[DV / 32], float& m, float& l, int lane, const MaskF& allowed) {
    const int r = lane & 31, h = lane >> 5;
    f32x16 s0, s1;
#pragma unroll
    for (int i = 0; i < 16; ++i) { s0[i] = 0.f; s1[i] = 0.f; }
    const LAS unsigned char* kb = Ks + r * KP + h * 16;
    __builtin_amdgcn_s_setprio(1);
#pragma unroll
    for (int ks = 0; ks < DQK / 16; ++ks) {
        if ((ks & 3) == 0 && ks) asm volatile("" ::: "memory");
        const bf16x8 a0 = *(const LAS bf16x8*)(kb + ks * 32);
        const bf16x8 a1 = *(const LAS bf16x8*)(kb + 32 * KP + ks * 32);
        s0 = MFMA32(a0, qf[ks], s0); s1 = MFMA32(a1, qf[ks], s1);
    }
    __builtin_amdgcn_s_setprio(0);
    constexpr bool PFV = (DQK <= 64);
    const int q4 = (lane & 15) >> 2, p4 = lane & 3, blk = (lane >> 4) & 1;
    const LAS unsigned char* vb = Vs + (4 * h + q4) * VP + (16 * blk + 4 * p4) * 2;
    bf16x8 vcur[DV / 32];
    if (PFV) {
#pragma unroll
        for (int dt = 0; dt < DV / 32; ++dt) { const s16x4 lo = tr_read(vb + dt * 64), hi = tr_read(vb + 8 * VP + dt * 64); vcur[dt] = __builtin_shufflevector(lo, hi, 0, 1, 2, 3, 4, 5, 6, 7); }
    }
    asm volatile("" ::: "memory");
    if (MASKED) {
#pragma unroll
        for (int i = 0; i < 16; ++i) { const int k0 = crow(i, h); if (!allowed(k0)) s0[i] = NEGBIG; if (!allowed(32 + k0)) s1[i] = NEGBIG; }
    }
    float mxa = max3f(s0[0], s0[1], s1[0]), mxb = max3f(s0[2], s0[3], s1[1]);
    mxa = max3f(mxa, s1[2], s1[3]);
#pragma unroll
    for (int i = 4; i < 16; i += 4) { mxa = max3f(mxa, s0[i], s0[i + 1]); mxb = max3f(mxb, s0[i + 2], s0[i + 3]); mxa = max3f(mxa, s1[i], s1[i + 1]); mxb = max3f(mxb, s1[i + 2], s1[i + 3]); }
    const float mx = xhalf_max(fmaxf(mxa, mxb));
    const float mn = (mx > m + 8.0f) ? mx : m;
    if (__builtin_amdgcn_ballot_w64(mn != m) != 0ull) {
        const float alpha = __builtin_amdgcn_exp2f(m - mn);
        l *= alpha;
#pragma unroll
        for (int dt = 0; dt < DV / 32; ++dt) o[dt] *= alpha;
        m = mn;
    }
    float ps0 = 0.f, ps1 = 0.f;
#pragma unroll
    for (int i = 0; i < 16; ++i) { s0[i] = __builtin_amdgcn_exp2f(s0[i] - mn); s1[i] = __builtin_amdgcn_exp2f(s1[i] - mn); ps0 += s0[i]; ps1 += s1[i]; }
    l += ps0 + ps1;
    bf16x8 pb[4];
#pragma unroll
    for (int s = 0; s < 2; ++s) {
        u32x4 w0, w1;
        w0.x = pk_bf16(s0[8 * s + 0], s0[8 * s + 1]); w0.y = pk_bf16(s0[8 * s + 2], s0[8 * s + 3]); w0.z = pk_bf16(s0[8 * s + 4], s0[8 * s + 5]); w0.w = pk_bf16(s0[8 * s + 6], s0[8 * s + 7]);
        w1.x = pk_bf16(s1[8 * s + 0], s1[8 * s + 1]); w1.y = pk_bf16(s1[8 * s + 2], s1[8 * s + 3]); w1.z = pk_bf16(s1[8 * s + 4], s1[8 * s + 5]); w1.w = pk_bf16(s1[8 * s + 6], s1[8 * s + 7]);
        pb[s] = __builtin_bit_cast(bf16x8, w0); pb[2 + s] = __builtin_bit_cast(bf16x8, w1);
    }
    __builtin_amdgcn_s_setprio(1);
#pragma unroll
    for (int g = 0; g < 4; ++g) {
        bf16x8 vnext[DV / 32];
        if (PFV) {
            if (g < 3) {
#pragma unroll
                for (int dt = 0; dt < DV / 32; ++dt) { const s16x4 lo = tr_read(vb + (16 * (g + 1)) * VP + dt * 64), hi = tr_read(vb + (16 * (g + 1) + 8) * VP + dt * 64); vnext[dt] = __builtin_shufflevector(lo, hi, 0, 1, 2, 3, 4, 5, 6, 7); }
            }
            asm volatile("" ::: "memory");
        } else {
            asm volatile("" ::: "memory");
#pragma unroll
            for (int dt = 0; dt < DV / 32; ++dt) { const s16x4 lo = tr_read(vb + (16 * g) * VP + dt * 64), hi = tr_read(vb + (16 * g + 8) * VP + dt * 64); vcur[dt] = __builtin_shufflevector(lo, hi, 0, 1, 2, 3, 4, 5, 6, 7); }
        }
#pragma unroll
        for (int dt = 0; dt < DV / 32; ++dt) o[dt] = MFMA32(vcur[dt], pb[g], o[dt]);
        if (PFV && g < 3) {
#pragma unroll
            for (int dt = 0; dt < DV / 32; ++dt) vcur[dt] = vnext[dt];
        }
    }
    __builtin_amdgcn_s_setprio(0);
}

template <int NCH, int N>
DI void tile_load(u32x4 (&reg)[N], const bf16_t* src  , int pitch, int tid) {
#pragma unroll
    for (int i = 0; i < N; ++i) { const int c = tid + 512 * i, key = c / NCH, part = c % NCH; reg[i] = *(const u32x4*)(src + (size_t)key * pitch + part * 8); }
}
template <int NCH, int N, int PB>
DI void tile_store(const u32x4 (&reg)[N], LAS unsigned char* buf, int tid) {
#pragma unroll
    for (int i = 0; i < N; ++i) { const int c = tid + 512 * i, key = c / NCH, part = c % NCH; *(LAS u32x4*)(buf + key * PB + part * 16) = reg[i]; }
}

template <int DQK, int DV>
DI void causal_attn(LAS unsigned char* lds, const bf16_t* Qp, int qpitch, const bf16_t* Kp, int kpitch, const bf16_t* Vp, int vpitch, int q0, f32x16 (&o)[DV / 32], int tid) {
    constexpr int KP = DQK * 2 + 16, VP = DV * 2 + 64, KBUF = 64 * KP, VBUF = 64 * VP;
    constexpr int KCH = DQK / 8, VCH = DV / 8, KN = 64 * KCH / 512, VN = 64 * VCH / 512;
    LAS unsigned char* Kb = lds; LAS unsigned char* Vb = lds + 2 * KBUF;
    const int lane = tid & 63, w = tid >> 6, r = lane & 31, h = lane >> 5, qw = q0 + 32 * w;
    const int qtrue = qw + r, qrow = qtrue < 0 ? 0 : (qtrue > LROW - 1 ? LROW - 1 : qtrue);
    bf16x8 qf[DQK / 16];
#pragma unroll
    for (int ks = 0; ks < DQK / 16; ++ks) qf[ks] = *(const bf16x8*)(Qp + (size_t)qrow * qpitch + ks * 16 + h * 8);
    float m = NEGBIG, l = 0.f;
#pragma unroll
    for (int dt = 0; dt < DV / 32; ++dt)
#pragma unroll
        for (int i = 0; i < 16; ++i) o[dt][i] = 0.f;
    const int qlast = (q0 + 255 > LROW - 1) ? LROW - 1 : q0 + 255, ktend = qlast >> 6;
    const bool wactive = (qw + 31 >= NFRONT);
    u32x4 kreg[KN], vreg[VN];
    tile_load<KCH, KN>(kreg, Kp + (size_t)64 * kpitch, kpitch, tid); tile_load<VCH, VN>(vreg, Vp + (size_t)64 * vpitch, vpitch, tid);
    tile_store<KCH, KN, KP>(kreg, Kb, tid); tile_store<VCH, VN, VP>(vreg, Vb, tid);
    __syncthreads();
    int cur = 0;
    for (int kt = 1; kt <= ktend; ++kt) {
        if (kt < ktend) { tile_load<KCH, KN>(kreg, Kp + (size_t)(64 * (kt + 1)) * kpitch, kpitch, tid); tile_load<VCH, VN>(vreg, Vp + (size_t)(64 * (kt + 1)) * vpitch, vpitch, tid); }
        if (wactive && 64 * kt <= qw + 31) {
            const LAS unsigned char* Ks = Kb + cur * KBUF; const LAS unsigned char* Vs = Vb + cur * VBUF;
            const int k64 = 64 * kt;
            auto allowed = [&](int slot) { const int kg = k64 + slot; return kg <= qtrue && kg >= NFRONT; };
            if (k64 + 63 > qw || kt == 1) attn_tile<DQK, DV, KP, VP, true>(Ks, Vs, qf, o, m, l, lane, allowed);
            else attn_tile<DQK, DV, KP, VP, false>(Ks, Vs, qf, o, m, l, lane, allowed);
        }
        if (kt < ktend) { tile_store<KCH, KN, KP>(kreg, Kb + (cur ^ 1) * KBUF, tid); tile_store<VCH, VN, VP>(vreg, Vb + (cur ^ 1) * VBUF, tid); }
        __syncthreads();
        cur ^= 1;
    }
    l = xhalf_sum(l);
    const float inv = 1.0f / l;
#pragma unroll
    for (int dt = 0; dt < DV / 32; ++dt) o[dt] *= inv;
}

template <int NDT>
DI void store_oT(bf16_t* dst, const f32x16 (&o)[NDT], int h, bool zero) {
#pragma unroll
    for (int dt = 0; dt < NDT; ++dt)
#pragma unroll
        for (int g = 0; g < 4; ++g) {
            u32x2 w; w.x = pk_bf16(o[dt][4 * g], o[dt][4 * g + 1]); w.y = pk_bf16(o[dt][4 * g + 2], o[dt][4 * g + 3]);
            if (zero) { w.x = 0u; w.y = 0u; }
            *(u32x2*)(dst + 32 * dt + 8 * g + 4 * h) = w;
        }
}

struct AttnL0 { const bf16_t *QA, *KA, *VA, *QM, *KM, *VM; bf16_t* OAB; gcf subln; float lam; };

DI void attn_unit_diff(LAS unsigned char* lds, const AttnL0& A, int b, int hh, int t, int tid) {
    const int lane = tid & 63, w = tid >> 6, r = lane & 31, h = lane >> 5, q0 = 256 * t - 128, qtrue = q0 + 32 * w + r;
    const size_t rb = (size_t)b * LROW;
    const bf16_t* Vp = A.VA + rb * 512 + hh * 128;
    LAS unsigned* o1s = (LAS unsigned*)(lds + 61440) + tid;
    {
        f32x16 o1[4];
        causal_attn<64, 128>(lds, A.QA + rb * 512 + hh * 128 + 64, 512, A.KA + rb * 512 + hh * 128 + 64, 512, Vp, 512, q0, o1, tid);
#pragma unroll
        for (int dt = 0; dt < 4; ++dt)
#pragma unroll
            for (int i = 0; i < 8; ++i) o1s[(dt * 8 + i) * 512] = pk_bf16(o1[dt][2 * i], o1[dt][2 * i + 1]);
    }
    f32x16 o[4];
    causal_attn<64, 128>(lds, A.QA + rb * 512 + hh * 128, 512, A.KA + rb * 512 + hh * 128, 512, Vp, 512, q0, o, tid);
    float ss = 0.f;
#pragma unroll
    for (int dt = 0; dt < 4; ++dt)
#pragma unroll
        for (int i = 0; i < 8; ++i) {
            const unsigned pw = o1s[(dt * 8 + i) * 512];
            const float x0 = o[dt][2 * i] - A.lam * bf_lo(pw), x1 = o[dt][2 * i + 1] - A.lam * bf_hi(pw);
            o[dt][2 * i] = x0; o[dt][2 * i + 1] = x1; ss += x0 * x0 + x1 * x1;
        }
    ss = xhalf_sum(ss);
    const float rs = rsqrtf(ss * (1.0f / 128) + 1e-5f) * 0.8f;
#pragma unroll
    for (int dt = 0; dt < 4; ++dt)
#pragma unroll
        for (int g = 0; g < 4; ++g) { const f32x4 sg = *(const GAS f32x4*)(A.subln + 32 * dt + 8 * g + 4 * h);
#pragma unroll
            for (int e = 0; e < 4; ++e) o[dt][4 * g + e] *= rs * sg[e]; }
    if (qtrue >= 0 && qtrue < LROW) store_oT<4>(A.OAB + (rb + qtrue) * 1024 + hh * 128, o, h, qtrue < NFRONT);
}
DI void attn_unit_mla(LAS unsigned char* lds, const AttnL0& A, int b, int hh, int t, int tid) {
    const int lane = tid & 63, w = tid >> 6, r = lane & 31, h = lane >> 5, q0 = 256 * t - 128, qtrue = q0 + 32 * w + r;
    const size_t rb = (size_t)b * LROW;
    f32x16 o[4];
    causal_attn<192, 128>(lds, A.QM + rb * 768 + hh * 192, 768, A.KM + rb * 768 + hh * 192, 768, A.VM + rb * 512 + hh * 128, 512, q0, o, tid);
    if (qtrue >= 0 && qtrue < LROW) store_oT<4>(A.OAB + (rb + qtrue) * 1024 + 512 + hh * 128, o, h, qtrue < NFRONT);
}

struct AttnL1 { const bf16_t *QS, *KS, *VS; bf16_t* OS; gcf sinks; };
DI void attn_unit_swa(LAS unsigned char* lds, const AttnL1& A, int b, int kvh, int n, int tid) {
    constexpr int KP = 144, VP = 192, NROW = 320;
    LAS unsigned char* Kb = lds; LAS unsigned char* Vb = lds + NROW * KP;
    const size_t rb = (size_t)b * LROW;
    for (int c = tid; c < NROW * 8; c += 512) {
        const int j = c >> 3, part = c & 7;
        int gr = (j < 256) ? 128 * (n - 1) + j : ((j < 272) ? NFRONT + (j - 256) : -1);
        u32x4 kv = {0u, 0u, 0u, 0u}, vv = {0u, 0u, 0u, 0u};
        if (gr >= 0) { kv = *(const u32x4*)(A.KS + (rb + gr) * 128 + kvh * 64 + part * 8); vv = *(const u32x4*)(A.VS + (rb + gr) * 128 + kvh * 64 + part * 8); }
        *(LAS u32x4*)(Kb + j * KP + part * 16) = kv; *(LAS u32x4*)(Vb + j * VP + part * 16) = vv;
    }
    __syncthreads();
    const int lane = tid & 63, g = tid >> 6, r = lane & 31, h = lane >> 5, head = kvh * 8 + g;
    const float sink = A.sinks[head] * LOG2E;
    for (int j = 0; j < 4; ++j) {
        const int qtrue = 128 * n + 32 * j + r;
        bf16x8 qf[4];
#pragma unroll
        for (int ks = 0; ks < 4; ++ks) qf[ks] = *(const bf16x8*)(A.QS + (rb + qtrue) * 1024 + head * 64 + ks * 16 + h * 8);
        float m = sink, l = (h == 0) ? 1.0f : 0.0f;
        f32x16 o[2];
#pragma unroll
        for (int dt = 0; dt < 2; ++dt)
#pragma unroll
            for (int i = 0; i < 16; ++i) o[dt][i] = 0.f;
        const int tb0 = (j < 2) ? 0 : 1;
        for (int tb = tb0; tb < tb0 + 3; ++tb) {
            const int kbase = 128 * (n - 1) + 64 * tb;
            auto allowed = [&](int slot) { const int kg = kbase + slot; return kg <= qtrue && kg >= NFRONT && (kg < 128 || qtrue - kg < 128); };
            attn_tile<64, 64, KP, VP, true>(Kb + 64 * tb * KP, Vb + 64 * tb * VP, qf, o, m, l, lane, allowed);
        }
        if (n >= 2) {
            auto allowed = [&](int slot) { return slot < 16; };
            attn_tile<64, 64, KP, VP, true>(Kb + 256 * KP, Vb + 256 * VP, qf, o, m, l, lane, allowed);
        }
        l = xhalf_sum(l);
        const float inv = 1.0f / l;
#pragma unroll
        for (int dt = 0; dt < 2; ++dt) o[dt] *= inv;
        store_oT<2>(A.OS + (rb + qtrue) * 1024 + head * 64, o, h, qtrue < NFRONT);
    }
    __syncthreads();
}
#define XB_TMO      128
#define XB_XCNT(j)  (256  + 64 * (j))
#define XB_XSUB(j)  (1280 + 64 * (j))
#define XB_XGEN(j)  (2304 + 64 * (j))
#define XB_TOP      3328
#define XB_TOPGEN   3392
#define XCD_BAR_WORDS 3456
#define XB_SPIN_CAP (1u << 18)

__device__ __forceinline__ unsigned xb_ld(unsigned* p)              { return __hip_atomic_load(p, __ATOMIC_RELAXED, __HIP_MEMORY_SCOPE_AGENT); }
__device__ __forceinline__ unsigned xb_add(unsigned* p, unsigned v) { return __hip_atomic_fetch_add(p, v, __ATOMIC_RELAXED, __HIP_MEMORY_SCOPE_AGENT); }
__device__ __forceinline__ unsigned xb_xcc_id() { return (unsigned)__builtin_amdgcn_s_getreg((3 << 11) | 20) & 0xFu; }
#define XB_SPIN(cond, bar) do { unsigned _sp = 0; while (cond) { __builtin_amdgcn_s_sleep(1); \
    if ((++_sp & 255u) == 0u) { if (xb_ld(&(bar)[XB_TMO])) break; if (_sp > XB_SPIN_CAP) { atomicAdd(&(bar)[XB_TMO], 1u); break; } } } } while (0)

struct XcdBarrier {
    unsigned* bar; unsigned x;
    volatile LAS unsigned* st;
};

__device__ __forceinline__ XcdBarrier xcd_barrier_post(unsigned* bar, volatile LAS unsigned* st) {
    XcdBarrier b; b.bar = bar; b.x = xb_xcc_id(); b.st = st;
    if (threadIdx.x == 0) (void)xb_add(&bar[XB_XCNT(b.x)], 1u);
    return b;
}
__device__ __forceinline__ void xcd_barrier_complete(unsigned* bar, unsigned x, unsigned& nloc, unsigned& nx) {
    const unsigned G = gridDim.x * gridDim.y * gridDim.z;
    unsigned sum, cnt, mine, sp = 0u;
    for (;;) {
        sum = 0u; cnt = 0u; mine = 0u;
#pragma unroll
        for (unsigned j = 0; j < 16; ++j) { const unsigned c = xb_ld(&bar[XB_XCNT(j)]); sum += c; cnt += (c > 0u) ? 1u : 0u; mine = (j == x) ? c : mine; }
        if (sum == G) break;
        __builtin_amdgcn_s_sleep(1);
        if ((++sp & 255u) == 0u) { if (xb_ld(&bar[XB_TMO])) break; if (sp > XB_SPIN_CAP) { atomicAdd(&bar[XB_TMO], 1u); break; } }
    }
    nloc = mine > 0u ? mine : 1u; nx = cnt > 0u ? cnt : 1u;
}

__device__ __forceinline__ void xcd_barrier(const XcdBarrier& b) {
    asm volatile("s_waitcnt vmcnt(0)" ::: "memory");
    __syncthreads();
    if (threadIdx.x == 0) {
        unsigned* bar = b.bar;
        __builtin_amdgcn_s_waitcnt(0);
        unsigned nloc = b.st[0], nx = b.st[1];
        if (nloc == 0u) { xcd_barrier_complete(bar, b.x, nloc, nx); b.st[0] = nloc; b.st[1] = nx; }
        const unsigned old = xb_add(&bar[XB_XSUB(b.x)], 1u);
        const unsigned gen = old / nloc;
        if (old + 1u == (gen + 1u) * nloc) {
            __builtin_amdgcn_fence(__ATOMIC_RELEASE, "agent");
            asm volatile("s_waitcnt vmcnt(0)" ::: "memory");
            const unsigned og = xb_add(&bar[XB_TOP], 1u);
            const unsigned tg = og / nx;
            if (og + 1u == (tg + 1u) * nx) xb_add(&bar[XB_TOPGEN], 1u);
            else XB_SPIN(xb_ld(&bar[XB_TOPGEN]) == tg, bar);
            __builtin_amdgcn_fence(__ATOMIC_ACQUIRE, "agent");
            xb_add(&bar[XB_XGEN(b.x)], 1u);
            asm volatile("s_waitcnt vmcnt(0)" ::: "memory");
        } else {
            XB_SPIN(xb_ld(&bar[XB_XGEN(b.x)]) == gen, bar);
            __builtin_amdgcn_fence(__ATOMIC_ACQUIRE, "agent");
            asm volatile("s_waitcnt vmcnt(0)" ::: "memory");
        }
    }
    __syncthreads();
}

DI int srccol(int kind, int nd) {
    if (kind == 1) return 128 * (nd >> 8) + (nd & 127);
    if (kind == 2) { if (nd < 1024) return (nd & ~63) + permP(nd & 63); if (nd < 2048) return nd; if (nd < 2112) return 2048 + permM(nd - 2048); return -1; }
    if (kind == 3) { const int hh = nd / 192, d = nd % 192; return hh * 192 + (d < 128 ? d : 128 + permM(d - 128)); }
    if (kind == 4) { if (nd < 1152) return (nd & ~63) + permP(nd & 63); return nd; }
    return nd;
}
DI void wt_item(gcf W, int ldw, int nsrc, int Kdim, int k0, int n0, int kind, gcf gain, bf16_t* WT, LAS float* scr, int lane) {
    const int sbase = (kind == 1) ? 128 * (n0 >> 8) : n0;
    const int c4 = (lane & 31) * 4;
    const bool okc = sbase + c4 < nsrc;
    f32x4 v[16];
#pragma unroll
    for (int i = 0; i < 16; ++i) {
        const int kk = 2 * i + (lane >> 5);
        v[i] = (f32x4){0.f, 0.f, 0.f, 0.f};
        if (okc) v[i] = *(const GAS f32x4*)(W + (size_t)(k0 + kk) * ldw + sbase + c4);
    }
#pragma unroll
    for (int i = 0; i < 16; ++i) {
        const int kk = 2 * i + (lane >> 5);
        if (gain) v[i] *= gain[k0 + kk];
        *(LAS f32x4*)(scr + kk * 132 + c4) = v[i];
    }
    asm volatile("s_waitcnt lgkmcnt(0)" ::: "memory");
    const int kq = lane >> 4;
#pragma unroll
    for (int j = 0; j < 8; ++j) {
        const int n = (lane & 15) + 16 * j;
        const int sc = srccol(kind, n0 + n);
        u32x4 o = {0u, 0u, 0u, 0u};
        if (sc >= 0) { const LAS float* s = scr + (8 * kq) * 132 + (sc - sbase);
            o.x = pk_bf16(s[0 * 132], s[1 * 132]); o.y = pk_bf16(s[2 * 132], s[3 * 132]); o.z = pk_bf16(s[4 * 132], s[5 * 132]); o.w = pk_bf16(s[6 * 132], s[7 * 132]); }
        *(u32x4*)(WT + (size_t)(n0 + n) * Kdim + k0 + 8 * kq) = o;
    }
    asm volatile("s_waitcnt lgkmcnt(0)" ::: "memory");
}
constexpr int I_GU = 32 * 44, I_DN = 88 * 8, I_FFN = I_GU + I_DN, I_WIN = 32 * 18, I_UQ = 8 * 6, I_UKV = 8 * 8, I_WO = 32 * 8, I_QKV = 32 * 10;
constexpr int W_ITEMS_L0 = 2 * I_FFN + I_WIN + I_UQ + I_UKV + I_WO, W_ITEMS = W_ITEMS_L0 + 2 * I_FFN + I_QKV + I_WO;
DI void convert_weights(unsigned char* ws, LAS unsigned char* lds, int tid, int it_lo, int it_hi, int gw, int NGW) {
    const int lane = tid & 63, wave = tid >> 6;
    LAS float* scr = (LAS float*)(lds + wave * 16896);
    bf16_t* WB = (bf16_t*)(ws + WS_W);
    for (int it = it_lo + gw; it < it_hi; it += NGW) {
        int r = it, lyr = 0;
        if (r >= W_ITEMS_L0) { r -= W_ITEMS_L0; lyr = 1; }
        if (r < 2 * I_FFN) {
            const int f = r / I_FFN, fi = 2 * lyr + f; r %= I_FFN;
            if (r < I_GU) {
                const int kb = r / 44, n0 = (r % 44) * 128;
                gcf W = (((n0 & 255) < 128) ? (f ? INP(24) : INP(3)) : (f ? INP(25) : INP(4))) + (size_t)lyr * D * FF;
                wt_item(W, FF, FF, D, kb * 32, n0, 1, (f ? INP(23) : INP(2)) + lyr * D, WB + WOFF_FFN + (size_t)fi * (W_GU + W_DN), scr, lane);
            } else {
                r -= I_GU;
                wt_item((f ? INP(26) : INP(5)) + (size_t)lyr * FF * D, D, D, FF, (r / 8) * 32, (r % 8) * 128, 0, nullptr, WB + WOFF_FFN + (size_t)fi * (W_GU + W_DN) + W_GU, scr, lane);
            }
            continue;
        }
        r -= 2 * I_FFN;
        if (lyr == 0) {
            if (r < I_WIN) { wt_item(INP(7), 2112, 2112, D, (r / 18) * 32, (r % 18) * 128, 2, INP(6), WB + WOFF_WIN, scr, lane); continue; } r -= I_WIN;
            if (r < I_UQ) { wt_item(INP(14), 768, 768, 256, (r / 6) * 32, (r % 6) * 128, 3, INP(13), WB + WOFF_UQ, scr, lane); continue; } r -= I_UQ;
            if (r < I_UKV) { wt_item(INP(16), 1024, 1024, 256, (r / 8) * 32, (r % 8) * 128, 0, INP(15), WB + WOFF_UKV, scr, lane); continue; } r -= I_UKV;
            wt_item(INP(17), 1024, 1024, D, (r / 8) * 32, (r % 8) * 128, 0, nullptr, WB + WOFF_WO0, scr, lane);
        } else {
            if (r < I_QKV) { wt_item(INP(18), 1280, 1280, D, (r / 10) * 32, (r % 10) * 128, 4, INP(6) + D, WB + WOFF_QKV, scr, lane); continue; } r -= I_QKV;
            wt_item(INP(21), 1024, 1024, D, (r / 8) * 32, (r % 8) * 128, 0, nullptr, WB + WOFF_WO1, scr, lane);
        }
    }
}

DI void prologue(const Args& a, LAS unsigned char* lds, int tid) {
    const int lane = tid & 63, wave = tid >> 6;
    const int gt = blockIdx.x * 512 + tid, nthr = gridDim.x * 512;
    const int gw = blockIdx.x * 8 + wave, NGW = gridDim.x * 8;
    float* ssq = (float*)(a.ws + WS_SSQ);
    for (int i = gt; i < 8 * R; i += nthr) ssq[R + i] = 0.f;
    if (gt < 256) ((unsigned*)(a.ws + WS_CTL))[gt] = 0u;
    for (int i = gt; i < XCD_BAR_WORDS; i += nthr) ((unsigned*)(a.ws + WS_CTL))[4096 + i] = 0u;
    {
        float2* tabP = (float2*)(a.ws + WS_TABP); float2* tabM = (float2*)(a.ws + WS_TABM);
        for (int e = gt; e < NPOS * 40; e += nthr) {
            const int pos = e / 40, i = e % 40;
            const double ex = (i < 8) ? (double)(2 * i) / 16.0 : (double)(2 * (i - 8)) / 64.0;
            const double inv = exp2(-ex * 18.931568569324174);
            double rev = (double)pos * inv * 0.15915494309189535;
            rev -= floor(rev);
            const float f = (float)rev;
            const float2 cs = make_float2(__builtin_amdgcn_cosf(f), __builtin_amdgcn_sinf(f));
            if (i < 8) tabP[pos * 8 + i] = cs; else tabM[pos * 32 + (i - 8)] = cs;
        }
    }
    { float* bp = (float*)(a.ws + WS_BQKV); gcf bq = INP(19); for (int i = gt; i < NQKV; i += nthr) bp[i] = bq[srccol(4, i)]; }
    {
        float* H = (float*)(a.ws + WS_H); bf16_t* HB = (bf16_t*)(a.ws + WS_HB);
        for (int row = gw; row < R; row += NGW) {
            const int b = row / LROW, i = row % LROW;
            gcf src = (i < NFRONT) ? nullptr : (i < 128 ? INP(1) + (size_t)(i - NFRONT) * D : INP(0) + ((size_t)b * SEQ + (i - 128)) * D);
            float s = 0.f;
#pragma unroll
            for (int j = 0; j < 4; ++j) {
                f32x4 v = {0.f, 0.f, 0.f, 0.f};
                if (src) v = *(const GAS f32x4*)(src + 256 * j + 4 * lane);
                *(f32x4*)(H + (size_t)row * D + 256 * j + 4 * lane) = v;
                u32x2 w; w.x = pk_bf16(v[0], v[1]); w.y = pk_bf16(v[2], v[3]);
                *(u32x2*)(HB + (size_t)row * D + 256 * j + 4 * lane) = w;
                s += (v[0] * v[0] + v[1] * v[1]) + (v[2] * v[2] + v[3] * v[3]);
            }
            s = wave_sum(s);
            if (lane == 0) ssq[row] = s;
        }
    }
    convert_weights(a.ws, lds, tid, 0, W_ITEMS_L0, gw, NGW);
}

constexpr int NPH_ = 23;
__global__ void __launch_bounds__(512, 2) fwd(Args a) {
    extern __shared__ __attribute__((aligned(16))) unsigned char lds_raw[];
    LAS unsigned char* lds = (LAS unsigned char*)lds_raw;
    volatile LAS unsigned* misc = (volatile LAS unsigned*)(lds + LDS_MISC);
    cg::grid_group grid = cg::this_grid();
    volatile LAS unsigned* xst = (volatile LAS unsigned*)(lds + 147392);
    if (threadIdx.x == 0) { xst[0] = 0u; xst[1] = 0u; }
    __syncthreads();
    int tid = threadIdx.x, bid = blockIdx.x;
    unsigned char* ws = a.ws;
#define ssq ((float*)(ws + WS_SSQ))
#define H ((float*)(ws + WS_H))
#define HB ((bf16_t*)(ws + WS_HB))
#define ACT ((bf16_t*)(ws + WS_ACT))
#define WB ((bf16_t*)(ws + WS_W))
#define tabP ((const float2*)(ws + WS_TABP))
#define tabM ((const float2*)(ws + WS_TABM))
#define QA ((bf16_t*)(ws + WS_QA))
#define KA ((bf16_t*)(ws + WS_KA))
#define VA ((bf16_t*)(ws + WS_VA))
#define QM ((bf16_t*)(ws + WS_QM))
#define CQ ((bf16_t*)(ws + WS_CQ))
#define CKV ((bf16_t*)(ws + WS_CKV))
#define KM ((bf16_t*)(ws + WS_KM))
#define OAB ((bf16_t*)((unsigned char*)a.out + OUT_OAB))
#define VM ((bf16_t*)((unsigned char*)a.out + OUT_VM))
#define QS ((bf16_t*)(ws + WS_QS))
#define KS ((bf16_t*)(ws + WS_KS))
#define VS ((bf16_t*)(ws + WS_VS))
#define OS ((bf16_t*)(ws + WS_OS))
    const int lo = a.ph_lo, hi = a.ph_hi;
#define IN(k) (lo <= (k) && (k) < hi)
#define REPS(k)
#define SEAM(k) do { if (IN(k) && IN((k) + 1)) { if ((k) == 0 || !(lo == 0 && hi == NPH_)) grid.sync(); else { XcdBarrier xb_; xb_.bar = (unsigned*)(a.ws + WS_CTL) + 4096; xb_.x = xb_xcc_id(); xb_.st = xst; xcd_barrier(xb_); } } } while (0)
#define RUN_GEMM(EpiT, E, Aptr, Bptr, N_, K_) do { int k_rt = (K_); asm volatile("" : "+s"(k_rt)); pg8::Gemm g{(Aptr), (Bptr), R, (N_), k_rt}; pg8::StaticOrder S; S.init(R, (N_), (int)gridDim.x, bid); \
        pg8::gemm_phase<EpiT, pg8::StaticOrder, true, true>(lds, g, S, (E)); } while (0)

#define LAUNDER_TID() do { tid = threadIdx.x; asm volatile("" : "+v"(tid)); { size_t z_ = 0; asm volatile("" : "+s"(z_)); ws = a.ws + z_; } bid = blockIdx.x; asm volatile("" : "+s"(bid)); } while (0)
#define RUN_RESID(E_, Aptr, Bptr, K_) do { int k_rt = (K_); asm volatile("" : "+s"(k_rt)); \
        pg8::StaticOrder S0; S0.init(R, D, (int)gridDim.x, bid); const int G_ = (int)gridDim.x, cap_ = (S0.nwg / G_) * G_, nleft_ = S0.nwg - cap_; \
        { pg8::Gemm g{(Aptr), (Bptr), R, D, k_rt, 0}; pg8::CapOrder S; S.init(R, D, G_, bid, cap_); pg8::gemm_phase<EpiResid, pg8::CapOrder, true, true>(lds, g, S, (E_)); } \
        { const int NS_ = k_rt >> 8; \
          for (int j_ = bid; j_ < nleft_ * NS_; j_ += G_) { const int e_ = j_ / NS_, sl_ = j_ % NS_; pg8::OneUnit S1; pg8::CapOrder::unit_of(S0, cap_ + e_, S1.u); \
              int nt_rt = 4; asm volatile("" : "+s"(nt_rt)); pg8::Gemm g{(Aptr) + sl_ * 256, (Bptr) + sl_ * 256, R, D, k_rt, nt_rt}; EpiPartial EA{(unsigned char*)a.out, e_, sl_}; pg8::gemm_phase<EpiPartial, pg8::OneUnit, true, true>(lds, g, S1, EA); } } } while (0)
#define RUN_FIXUP(ssq_idx_, has_bias_, alpha_, NS_) do { pg8::StaticOrder S0; S0.init(R, D, (int)gridDim.x, bid); const int G_ = (int)gridDim.x, cap_ = (S0.nwg / G_) * G_, nleft_ = S0.nwg - cap_; \
        const int lane_ = tid & 63; float* ssqo_ = ssq + (size_t)(ssq_idx_) * R; \
        for (int idx_ = bid * 8 + (tid >> 6); idx_ < nleft_ * 256; idx_ += G_ * 8) { const int e_ = idx_ >> 8, rl_ = idx_ & 255; pg8::Unit u_; pg8::CapOrder::unit_of(S0, cap_ + e_, u_); \
            const int row_ = u_.pm * 256 + rl_, c_ = u_.pn * 256 + lane_ * 4; const float* sp_ = (const float*)((unsigned char*)a.out + OUT_SPLIT) + (size_t)e_ * 11 * 65536 + rl_ * 256 + lane_ * 4; \
            f32x4 acc_ = *(const f32x4*)sp_; \
            _Pragma("unroll") for (int s_ = 1; s_ < (NS_); ++s_) acc_ += *(const f32x4*)(sp_ + (size_t)s_ * 65536); \
            f32x4 h4_ = *(const f32x4*)(H + (size_t)row_ * D + c_) + acc_ * (alpha_); \
            if (has_bias_) h4_ += *(const GAS f32x4*)(INP(22) + c_); \
            *(f32x4*)(H + (size_t)row_ * D + c_) = h4_; u32x2 w_; w_.x = pk_bf16(h4_[0], h4_[1]); w_.y = pk_bf16(h4_[2], h4_[3]); *(u32x2*)(HB + (size_t)row_ * D + c_) = w_; \
            const float ss_ = wave_sum((h4_[0] * h4_[0] + h4_[1] * h4_[1]) + (h4_[2] * h4_[2] + h4_[3] * h4_[3])); if (lane_ == 0) atomicAdd(ssqo_ + row_, ss_); } } while (0)
    if (IN(0)) { LAUNDER_TID(); REPS(0) { prologue(a, lds, tid); __syncthreads(); } }
    SEAM(0);
    if (lo == 0 && hi == NPH_) (void)xcd_barrier_post((unsigned*)(a.ws + WS_CTL) + 4096, xst);
    int ph = 1;
    for (int l = 0; l < 2; ++l) {
        const bf16_t* Wgu1 = WB + WOFF_FFN + (size_t)(2 * l) * (W_GU + W_DN);
        if (IN(ph)) { LAUNDER_TID(); EpiSwiglu E{ws, 3 * l}; REPS(ph) RUN_GEMM(EpiSwiglu, E, HB, Wgu1, 5632, D); }
        SEAM(ph); ++ph;
        if (IN(ph)) { LAUNDER_TID(); EpiResid E{ws, 3 * l + 1, 0, 0.5f}; RUN_RESID(E, ACT, Wgu1 + W_GU, FF);
            if (l == 0) convert_weights(ws, lds, tid, W_ITEMS_L0, W_ITEMS, bid * 8 + (tid >> 6), (int)gridDim.x * 8); }
        SEAM(ph); ++ph;
        if (IN(ph)) { LAUNDER_TID(); RUN_FIXUP(3 * l + 1, 0, 0.5f, 11); }
        SEAM(ph); ++ph;
        if (l == 0) {
            if (IN(ph)) { LAUNDER_TID(); EpiWin E{ws, 0.125f * LOG2E}; RUN_GEMM(EpiWin, E, HB, WB + WOFF_WIN, NWIN, D); }
            SEAM(ph); ++ph;
            if (IN(ph)) { LAUNDER_TID();
                REPS(ph) { EpiUq E{ws, 0.07216878364870322f * LOG2E}; RUN_GEMM(EpiUq, E, CQ, WB + WOFF_UQ, NUQ, 256); }
                REPS(ph) { EpiUkv E{ws, (unsigned char*)a.out}; RUN_GEMM(EpiUkv, E, CKV, WB + WOFF_UKV, NUKV, 256); }
            }
            SEAM(ph); ++ph;
            if (IN(ph)) { LAUNDER_TID();
                LAUNDER_TID();
                if (tid < 64) {
                    const float s1 = wave_sum(INP(8)[tid] * INP(9)[tid]), s2 = wave_sum(INP(10)[tid] * INP(11)[tid]);
                    if (tid == 0) misc[1] = __float_as_uint(__expf(s1) - __expf(s2) + 0.2f);
                }
                __syncthreads();
                AttnL0 A{QA, KA, VA, QM, KM, VM, OAB, INP(12), __uint_as_float(misc[1])};
                unsigned* qctr = (unsigned*)(ws + WS_CTL);
                REPS(ph) {
                for (;;) {
                    if (tid == 0) misc[0] = atomicAdd(qctr, 1u);
                    __syncthreads();
                    const unsigned idx = misc[0];
                    __syncthreads();
                    if (idx >= 33u * 16u) break;
                    const int t = 32 - (int)(idx >> 4), rem = idx & 15;
                    attn_unit_diff(lds, A, rem & 3, rem >> 2, t, tid);
                }
                asm volatile("" ::: "memory");
                for (;;) {
                    if (tid == 0) misc[0] = atomicAdd(qctr + 64, 1u);
                    __syncthreads();
                    const unsigned idx = misc[0];
                    __syncthreads();
                    if (idx >= 33u * 16u) break;
                    const int t = 32 - (int)(idx >> 4), rem = idx & 15;
                    attn_unit_mla(lds, A, rem & 3, rem >> 2, t, tid);
                }
                }
            }
            SEAM(ph); ++ph;
            if (IN(ph)) { LAUNDER_TID(); EpiResid E{ws, 2, 0, 1.0f}; RUN_RESID(E, OAB, WB + WOFF_WO0, D); }
            SEAM(ph); ++ph;
            if (IN(ph)) { LAUNDER_TID(); RUN_FIXUP(2, 0, 1.0f, 4); }
            SEAM(ph); ++ph;
        } else {
            if (IN(ph)) { LAUNDER_TID(); EpiQkvS E{ws, 0.125f * LOG2E}; RUN_GEMM(EpiQkvS, E, HB, WB + WOFF_QKV, NQKV, D); }
            SEAM(ph); ++ph;
            if (IN(ph)) { LAUNDER_TID();
                LAUNDER_TID();
                AttnL1 A{QS, KS, VS, OS, INP(20)};
                REPS(ph) for (int u = bid; u < NB * 2 * 65; u += gridDim.x) { const int b = u / 130, rem = u % 130; attn_unit_swa(lds, A, b, rem / 65, rem % 65, tid); }
            }
            SEAM(ph); ++ph;
            if (IN(ph)) { LAUNDER_TID(); EpiResid E{ws, 5, 1, 1.0f}; RUN_RESID(E, OS, WB + WOFF_WO1, D); }
            SEAM(ph); ++ph;
            if (IN(ph)) { LAUNDER_TID(); RUN_FIXUP(5, 1, 1.0f, 4); }
            SEAM(ph); ++ph;
        }
        const bf16_t* Wgu2 = WB + WOFF_FFN + (size_t)(2 * l + 1) * (W_GU + W_DN);
        if (IN(ph)) { LAUNDER_TID(); EpiSwiglu E{ws, 3 * l + 2}; REPS(ph) RUN_GEMM(EpiSwiglu, E, HB, Wgu2, 5632, D); }
        SEAM(ph); ++ph;
        if (IN(ph)) { LAUNDER_TID(); EpiResid E{ws, 3 * l + 3, 0, 0.5f}; RUN_RESID(E, ACT, Wgu2 + W_GU, FF); }
        SEAM(ph); ++ph;
        if (IN(ph)) { LAUNDER_TID(); RUN_FIXUP(3 * l + 3, 0, 0.5f, 11); }
        SEAM(ph); ++ph;
    }
    if (IN(ph)) { LAUNDER_TID();
        LAUNDER_TID();
        const int lane = tid & 63, gw = bid * 8 + (tid >> 6), NGW = gridDim.x * 8;
        gcf gf = INP(27);
        REPS(ph) for (int s = gw; s < NB * SEQ; s += NGW) {
            const int row = (s / SEQ) * LROW + 128 + (s % SEQ);
            const float rstd = rsqrtf(ssq[(size_t)6 * R + row] * (1.0f / D) + EPS);
#pragma unroll
            for (int j = 0; j < 4; ++j) {
                const f32x4 v = *(const f32x4*)(H + (size_t)row * D + 256 * j + 4 * lane), gg = *(const GAS f32x4*)(gf + 256 * j + 4 * lane);
                *(f32x4*)(a.out + (size_t)s * D + 256 * j + 4 * lane) = v * rstd * gg;
            }
        }
    }
}
constexpr int NPH = 23;

extern "C" void kernel_launch(void* const* d_in, const int* in_sizes, int n_in, void* d_out, int out_size, void* d_ws, size_t ws_size, hipStream_t stream) {
    static int grid = 0;
    if (grid == 0) {
        if (n_in != 28 || out_size != NB * SEQ * D || ws_size < WS_END) { fprintf(stderr, "kernel_launch: unexpected problem (n_in %d out %d ws %zu)\n", n_in, out_size, ws_size); grid = -1; return; }
        int dev = 0, cus = 0, per = 0;
        (void)hipGetDevice(&dev); (void)hipDeviceGetAttribute(&cus, hipDeviceAttributeMultiprocessorCount, dev);
        (void)hipFuncSetAttribute((const void*)fwd, hipFuncAttributeMaxDynamicSharedMemorySize, LDS_BYTES);
        (void)hipOccupancyMaxActiveBlocksPerMultiprocessor(&per, (const void*)fwd, 512, LDS_BYTES);
        (void)hipGetLastError();
        grid = cus > 0 ? cus : 256;
    }
    if (grid < 0) return;
    Args a{};
    for (int i = 0; i < 28; ++i) a.in[i] = (const float*)d_in[i];
    a.out = (float*)d_out; a.ws = (unsigned char*)d_ws;
#if MK_PER_PHASE
    for (int p = 0; p < NPH; ++p) {
        const int reps = ((PROBE_MASK >> p) & 1u) ? PROBE_N : 1;
        for (int r = 0; r < reps; ++r) {
            if (p == 6 && r > 0) (void)hipMemsetAsync(d_ws, 0, 1024, stream);
            a.ph_lo = p; a.ph_hi = p + 1; hipLaunchKernelGGL(fwd, dim3(grid), dim3(512), LDS_BYTES, stream, a);
        }
    }
#else
    a.ph_lo = 0; a.ph_hi = NPH;
    void* args[] = {&a};
    hipError_t e = hipLaunchCooperativeKernel((const void*)fwd, dim3(grid), dim3(512), args, LDS_BYTES, stream);
    if (e != hipSuccess) fprintf(stderr, "cooperative launch failed: %s (grid %d)\n", hipGetErrorString(e), grid);
#endif
}
```

```cpp
#include <hip/hip_runtime.h>
#include <hip/hip_cooperative_groups.h>
#include <cstdio>
#include <cstdint>
#include <cmath>
namespace cg = cooperative_groups;
#ifndef MK_PER_PHASE
#define MK_PER_PHASE 0
#endif
#ifndef PROBE_MASK
#define PROBE_MASK 0u
#endif
#ifndef PROBE_N
#define PROBE_N 2
#endif
namespace pg8 {
#define PG8_LAS __attribute__((address_space(3)))
typedef unsigned short bf16_t;
typedef short bf16x8 __attribute__((ext_vector_type(8)));
typedef float f32x4 __attribute__((ext_vector_type(4)));
typedef unsigned u32x4 __attribute__((ext_vector_type(4)));
constexpr int BM = 256, BK = 64, HALF = 128, HTB = HALF * BK * 2  , STAGE_BYTES = 8 * HTB, NXCD = 8, WGM = 8;

__host__ __device__ __forceinline__ int lds_byte(int r, int c) { const int st = (r >> 4) * 2 + (c >> 5), rr = r & 15, cc = c & 31, ob = rr * 64 + cc * 2; return st * 1024 + (ob ^ (((ob >> 9) & 1) << 5)); }
__host__ __device__ __forceinline__ void stage_rc(int b, int& R, int& C) { const int st = b / 1024, sb = b % 1024, swz = sb ^ (((sb >> 9) & 1) << 5); R = (st >> 1) * 16 + swz / 64; C = (st & 1) * 32 + (swz % 64) / 2; }
__host__ __device__ __forceinline__ int perm32(int rho) { const int n = rho >> 4, i = rho & 15; return 8 * (i >> 2) + 4 * n + (i & 3); }

struct Unit { int pm, pn; };
struct Gemm { const bf16_t* A; const bf16_t* Bt; int M, N, K, nt; };

struct StaticOrder {
    int nM, nN, nwg, G, c;
    __host__ __device__ void init(int M, int N, int G_, int c_) { nM = M / BM; nN = N / BM; nwg = nM * nN; G = G_; c = c_; }
    __host__ __device__ bool next(int i, Unit& u) const {
        const long L = (long)i * G + c; if (L >= nwg) return false;
        int wgid = (int)L; { const int q = nwg / NXCD, r = nwg % NXCD, xcd = wgid % NXCD, off = wgid / NXCD; wgid = (xcd < r ? xcd * (q + 1) : r * (q + 1) + (xcd - r) * q) + off; }
        const int nig = WGM * nN, gid = wgid / nig, fm = gid * WGM, gsz = (nM - fm) < WGM ? (nM - fm) : WGM;
        u.pm = fm + ((wgid % nig) % gsz); u.pn = (wgid % nig) / gsz; return true;
    }
    __device__ __forceinline__ void a_ready(const Unit&) const {}
    __device__ __forceinline__ void done(const Unit&) const {}
};
struct CapOrder {
    StaticOrder b; int cap;
    __host__ __device__ void init(int M, int N, int G_, int c_, int cap_) { b.init(M, N, G_, c_); cap = cap_; }
    __host__ __device__ __forceinline__ static void unit_of(const StaticOrder& o, int L, Unit& u) {
        int wgid = L; { const int q = o.nwg / NXCD, r = o.nwg % NXCD, xcd = wgid % NXCD, off = wgid / NXCD; wgid = (xcd < r ? xcd * (q + 1) : r * (q + 1) + (xcd - r) * q) + off; }
        const int nig = WGM * o.nN, gid = wgid / nig, fm = gid * WGM, gsz = (o.nM - fm) < WGM ? (o.nM - fm) : WGM;
        u.pm = fm + ((wgid % nig) % gsz); u.pn = (wgid % nig) / gsz;
    }
    __host__ __device__ __forceinline__ bool next(int i, Unit& u) const { const long L = (long)i * b.G + b.c; if (L >= cap) return false; unit_of(b, (int)L, u); return true; }
    __device__ __forceinline__ void a_ready(const Unit&) const {}
    __device__ __forceinline__ void done(const Unit&) const {}
};
struct OneUnit {
    Unit u;
    __host__ __device__ __forceinline__ bool next(int i, Unit& o) const { if (i != 0) return false; o = u; return true; }
    __device__ __forceinline__ void a_ready(const Unit&) const {}
    __device__ __forceinline__ void done(const Unit&) const {}
};


__device__ __forceinline__ unsigned cvt_pk_bf16(float lo, float hi) { unsigned r; asm volatile("v_cvt_pk_bf16_f32 %0, %1, %2" : "=v"(r) : "v"(lo), "v"(hi)); return r; }
template <class Epi, class Sched, bool ALIGN_EPI = false, bool SP2 = false>
__device__ __forceinline__ void gemm_phase(PG8_LAS unsigned char* lds, const Gemm g, const Sched& S, const Epi& E) {
    int tid_l = threadIdx.x; asm volatile("" : "+v"(tid_l)); const int tid = tid_l, wid = __builtin_amdgcn_readfirstlane(tid >> 6), lane = tid & 63, wr = wid >> 2, wc = wid & 3, fr = lane & 15, fq = lane >> 4;
    const int K = g.K, nt = g.nt > 0 ? g.nt : K / BK;
    unsigned voffA[2], voffB[2];
#pragma unroll
    for (int i = 0; i < 2; ++i) { int R, C; stage_rc(tid * 16 + i * 8192, R, C); const int Rb = Epi::PERM ? ((R & ~31) + perm32(R & 31)) : R;
        voffA[i] = (unsigned)(R * K + C) * 2u; voffB[i] = (unsigned)(Rb * K + C) * 2u; }
    const size_t kstep = (size_t)(BK * 2);
    const size_t hstep = (size_t)HALF * K * 2;
    const size_t tstep = 2 * hstep;
    const unsigned ldsw = (unsigned)wid * 1024u;
    const int aoff = lds_byte(wr * 64 + fr, fq * 8), boff = lds_byte(wc * 32 + fr, fq * 8);
#define PG8_SA(b, h) (((b) * 2 + (h)) * HTB)
#define PG8_SB(b, h) ((4 + (b) * 2 + (h)) * HTB)
#define PG8_STAGE(bufoff, gbase, voff) do { _Pragma("unroll") for (int _i = 0; _i < 2; ++_i) \
        __builtin_amdgcn_global_load_lds((const unsigned*)((const char*)(gbase) + (voff)[_i]), (PG8_LAS unsigned*)(lds + (bufoff) + ldsw + _i * 8192), 16, 0, 0); } while (0)
#define PG8_LDA(dst, b, h) do { _Pragma("unroll") for (int m = 0; m < 4; ++m) _Pragma("unroll") for (int k = 0; k < 2; ++k) dst[m][k] = *(const PG8_LAS bf16x8*)(lds + PG8_SA(b, h) + aoff + m * 2048 + k * 1024); } while (0)
#define PG8_LDB(dst, b, h) do { _Pragma("unroll") for (int n = 0; n < 2; ++n) _Pragma("unroll") for (int k = 0; k < 2; ++k) dst[n][k] = *(const PG8_LAS bf16x8*)(lds + PG8_SB(b, h) + boff + n * 2048 + k * 1024); } while (0)
#define PG8_MMA(ai, bj, At, Bt) do { __builtin_amdgcn_s_setprio(1); _Pragma("unroll") for (int m = 0; m < 4; ++m) _Pragma("unroll") for (int n = 0; n < 2; ++n) _Pragma("unroll") for (int k = 0; k < 2; ++k) \
        acc[ai][bj][m][n] = __builtin_amdgcn_mfma_f32_16x16x32_bf16(Bt[n][k], At[m][k], acc[ai][bj][m][n], 0, 0, 0); __builtin_amdgcn_s_setprio(0); } while (0)
#define PG8_WAIT_V(n) asm volatile("s_waitcnt vmcnt(" #n ")" ::: "memory")
#define PG8_WAIT_L(n) asm volatile("s_waitcnt lgkmcnt(" #n ")" ::: "memory")
#define PG8_BAR __builtin_amdgcn_s_barrier()
#define PG8_SCHED __builtin_amdgcn_sched_barrier(0)
    Unit cur, nxt; int ui = 0;
    if (!S.next(0, cur)) return;
    f32x4 acc[2][2][4][2];
#pragma unroll
    for (int a = 0; a < 2; ++a)
#pragma unroll
        for (int b = 0; b < 2; ++b)
#pragma unroll
            for (int m = 0; m < 4; ++m)
#pragma unroll
                for (int n = 0; n < 2; ++n) acc[a][b][m][n] = (f32x4){0.f, 0.f, 0.f, 0.f};
    bf16x8 At[4][2], B0[2][2], B1[2][2];
    const char* cA = (const char*)g.A + (size_t)cur.pm * tstep; const char* cB = (const char*)g.Bt + (size_t)cur.pn * tstep;
    S.a_ready(cur);
    if constexpr (SP2) {
        PG8_STAGE(PG8_SB(0, 0), cB, voffB); PG8_STAGE(PG8_SB(0, 1), cB + hstep, voffB); PG8_STAGE(PG8_SA(0, 0), cA, voffA); PG8_STAGE(PG8_SA(0, 1), cA + hstep, voffA);
        if (wr == 1) PG8_BAR;
        PG8_WAIT_V(2); PG8_BAR;
        PG8_STAGE(PG8_SB(1, 0), cB + kstep, voffB); PG8_STAGE(PG8_SA(1, 0), cA + kstep, voffA); PG8_STAGE(PG8_SB(1, 1), cB + hstep + kstep, voffB);
        PG8_WAIT_V(6); PG8_BAR;
    } else {
        PG8_STAGE(PG8_SB(0, 0), cB, voffB); PG8_STAGE(PG8_SA(0, 0), cA, voffA); PG8_STAGE(PG8_SB(0, 1), cB + hstep, voffB); PG8_STAGE(PG8_SA(0, 1), cA + hstep, voffA);
        if (wr == 1) PG8_BAR;
        PG8_WAIT_V(4); PG8_BAR;
        PG8_STAGE(PG8_SB(1, 0), cB + kstep, voffB); PG8_STAGE(PG8_SA(1, 0), cA + kstep, voffA); PG8_STAGE(PG8_SB(1, 1), cB + hstep + kstep, voffB);
        PG8_WAIT_V(6); PG8_BAR;
    }
    for (;;) {
        const bool has_next = S.next(ui + 1, nxt);
        const char* nA = has_next ? (const char*)g.A + (size_t)nxt.pm * tstep : cA; const char* nB = has_next ? (const char*)g.Bt + (size_t)nxt.pn * tstep : cB;
        for (int t = 0; t < nt; t += 2) {
            const bool last = (t == nt - 2);
            const char* a1 = cA + (size_t)(t + 1) * kstep;
            const char* a2 = last ? nA : cA + (size_t)(t + 2) * kstep; const char* b2 = last ? nB : cB + (size_t)(t + 2) * kstep;
            const char* a3 = a2 + kstep; const char* b3 = b2 + kstep;
            if (last && has_next) S.a_ready(nxt);
            if constexpr (SP2) {
            PG8_LDB(B0, 0, 0); PG8_LDB(B1, 0, 1); PG8_SCHED; PG8_LDA(At, 0, 0); PG8_STAGE(PG8_SA(1, 1), a1 + hstep, voffA);
            PG8_WAIT_V(8); PG8_WAIT_L(0); PG8_BAR; PG8_MMA(0, 0, At, B0); PG8_MMA(0, 1, At, B1); PG8_BAR; PG8_SCHED;
            PG8_LDA(At, 0, 1); PG8_STAGE(PG8_SB(0, 0), b2, voffB); PG8_STAGE(PG8_SB(0, 1), b2 + hstep, voffB); PG8_STAGE(PG8_SA(0, 0), a2, voffA);
            PG8_WAIT_V(8); PG8_WAIT_L(0); PG8_BAR; PG8_MMA(1, 0, At, B0); PG8_MMA(1, 1, At, B1); PG8_BAR; PG8_SCHED;
            PG8_LDB(B0, 1, 0); PG8_LDB(B1, 1, 1); PG8_SCHED; PG8_LDA(At, 1, 0); PG8_STAGE(PG8_SA(0, 1), a2 + hstep, voffA);
            PG8_WAIT_V(8); PG8_WAIT_L(0); PG8_BAR; PG8_MMA(0, 0, At, B0); PG8_MMA(0, 1, At, B1); PG8_BAR; PG8_SCHED;
            PG8_LDA(At, 1, 1); PG8_STAGE(PG8_SB(1, 0), b3, voffB); PG8_STAGE(PG8_SB(1, 1), b3 + hstep, voffB); PG8_STAGE(PG8_SA(1, 0), a3, voffA);
            PG8_WAIT_V(8); PG8_WAIT_L(0); PG8_BAR; PG8_MMA(1, 0, At, B0); PG8_MMA(1, 1, At, B1); PG8_BAR; PG8_SCHED;
            } else {
            PG8_LDB(B0, 0, 0); PG8_SCHED; PG8_LDA(At, 0, 0); PG8_STAGE(PG8_SA(1, 1), a1 + hstep, voffA);
            PG8_WAIT_L(8); PG8_BAR; PG8_WAIT_L(0); PG8_MMA(0, 0, At, B0); PG8_BAR; PG8_SCHED;
            PG8_LDB(B1, 0, 1); PG8_STAGE(PG8_SB(0, 0), b2, voffB);
            PG8_BAR; PG8_WAIT_L(0); PG8_MMA(0, 1, At, B1); PG8_BAR;
            PG8_LDA(At, 0, 1); PG8_STAGE(PG8_SA(0, 0), a2, voffA);
            PG8_BAR; PG8_WAIT_L(0); PG8_MMA(1, 0, At, B0); PG8_BAR; PG8_SCHED;
            PG8_STAGE(PG8_SB(0, 1), b2 + hstep, voffB);
            PG8_WAIT_V(6); PG8_BAR; PG8_MMA(1, 1, At, B1); PG8_BAR;
            PG8_LDB(B0, 1, 0); PG8_SCHED; PG8_LDA(At, 1, 0); PG8_STAGE(PG8_SA(0, 1), a2 + hstep, voffA);
            PG8_WAIT_L(8); PG8_BAR; PG8_WAIT_L(0); PG8_MMA(0, 0, At, B0); PG8_BAR; PG8_SCHED;
            PG8_LDB(B1, 1, 1); PG8_STAGE(PG8_SB(1, 0), b3, voffB);
            PG8_BAR; PG8_WAIT_L(0); PG8_MMA(0, 1, At, B1); PG8_BAR;
            PG8_LDA(At, 1, 1); PG8_STAGE(PG8_SA(1, 0), a3, voffA);
            PG8_BAR; PG8_WAIT_L(0); PG8_MMA(1, 0, At, B0); PG8_BAR; PG8_SCHED;
            PG8_STAGE(PG8_SB(1, 1), b3 + hstep, voffB);
            PG8_WAIT_V(6); PG8_BAR; PG8_MMA(1, 1, At, B1); PG8_BAR;
            }
        }
        if constexpr (ALIGN_EPI) { if (wr == 0) PG8_BAR; }
        if constexpr (!Epi::AFTER_DRAIN) { E(acc, cur, wr, wc, fr, fq); S.done(cur); }
        if (!has_next) break;
#pragma unroll
        for (int a = 0; a < 2; ++a)
#pragma unroll
            for (int b = 0; b < 2; ++b)
#pragma unroll
                for (int m = 0; m < 4; ++m)
#pragma unroll
                    for (int n = 0; n < 2; ++n) acc[a][b][m][n] = (f32x4){0.f, 0.f, 0.f, 0.f};
        cur = nxt; cA = nA; cB = nB; ++ui;
        if constexpr (ALIGN_EPI) { if (wr == 1) PG8_BAR; }
    }
    PG8_WAIT_V(0);
    if constexpr (!ALIGN_EPI) { if (wr == 0) PG8_BAR; }
    PG8_BAR;
    if constexpr (Epi::AFTER_DRAIN) { E.fused(acc, cur, wr, wc, fr, fq, lds, wid, lane); S.done(cur); }
#undef PG8_SA
#undef PG8_SB
#undef PG8_STAGE
#undef PG8_LDA
#undef PG8_LDB
#undef PG8_MMA
#undef PG8_WAIT_V
#undef PG8_WAIT_L
#undef PG8_BAR
#undef PG8_SCHED
}
}
#define LAS __attribute__((address_space(3)))
#define DI __device__ __forceinline__
typedef unsigned short bf16_t;
typedef short bf16x8 __attribute__((ext_vector_type(8)));
typedef short s16x4 __attribute__((ext_vector_type(4)));
typedef float f32x4 __attribute__((ext_vector_type(4)));
typedef float f32x16 __attribute__((ext_vector_type(16)));
typedef unsigned u32x4 __attribute__((ext_vector_type(4)));
typedef unsigned u32x2 __attribute__((ext_vector_type(2)));
typedef float f32x2_t __attribute__((ext_vector_type(2)));
typedef __bf16 bf16x2_t __attribute__((ext_vector_type(2)));

constexpr int NB = 4, SEQ = 8192, LROW = 8320, R = NB * LROW, D = 1024, FF = 2816, NFRONT = 112, NPOS = 8208;
constexpr int NWIN = 2304, NUQ = 768, NUKV = 1024, NQKV = 1280;
constexpr float LOG2E = 1.4426950408889634f;
constexpr float NEGBIG = -1e30f;
constexpr float EPS = 1e-6f;

constexpr size_t MiB = 1u << 20;
constexpr size_t WS_CTL = 0;
constexpr size_t WS_SSQ = 1 * MiB;
constexpr size_t WS_TABP = 3 * MiB;
constexpr size_t WS_TABM = WS_TABP + 768 * 1024;
constexpr size_t WS_W = 6 * MiB;
constexpr size_t W_GU = (size_t)5632 * 1024, W_DN = (size_t)1024 * 2816;
constexpr size_t WOFF_FFN = 0;
constexpr size_t WOFF_WIN = 4 * (W_GU + W_DN);
constexpr size_t WOFF_UQ = WOFF_WIN + (size_t)NWIN * 1024;
constexpr size_t WOFF_UKV = WOFF_UQ + (size_t)NUQ * 256;
constexpr size_t WOFF_WO0 = WOFF_UKV + (size_t)NUKV * 256;
constexpr size_t WOFF_QKV = WOFF_WO0 + (size_t)1024 * 1024;
constexpr size_t WOFF_WO1 = WOFF_QKV + (size_t)NQKV * 1024;
constexpr size_t W_TOTAL = WOFF_WO1 + (size_t)1024 * 1024;
constexpr size_t WS_BQKV = WS_W + 80 * MiB;
static_assert(W_TOTAL * 2 <= 79 * MiB, "weights fit");
constexpr size_t WS_H = 87 * MiB;
constexpr size_t WS_HB = WS_H + (size_t)R * D * 4;
constexpr size_t WS_ACT = WS_HB + (size_t)R * D * 2;
constexpr size_t SZ512 = (size_t)R * 512 * 2, SZ768 = (size_t)R * 768 * 2, SZ256 = (size_t)R * 256 * 2;
constexpr size_t WS_QA = WS_ACT, WS_KA = WS_QA + SZ512, WS_VA = WS_KA + SZ512, WS_QM = WS_VA + SZ512, WS_CQ = WS_QM + SZ768, WS_CKV = WS_CQ + SZ256;
static_assert(WS_CKV + SZ256 <= WS_ACT + (size_t)R * FF * 2, "layer-0 attention inputs overlay act");
constexpr size_t WS_KM = WS_ACT + (size_t)R * FF * 2;
constexpr size_t WS_END = WS_KM + SZ768;
static_assert(WS_END <= 512 * MiB, "d_ws map fits 512 MiB");
constexpr size_t WS_QS = WS_ACT, WS_KS = WS_QS + (size_t)R * 1024 * 2, WS_VS = WS_KS + (size_t)R * 128 * 2, WS_OS = WS_VS + (size_t)R * 128 * 2;
static_assert(WS_OS + (size_t)R * 1024 * 2 <= WS_KM, "layer-1 attention buffers overlay act");
constexpr size_t OUT_OAB = 0, OUT_VM = (size_t)R * 1024 * 2;
constexpr size_t OUT_SPLIT = 98 * MiB;
static_assert(OUT_VM + SZ512 <= OUT_SPLIT && OUT_SPLIT + (size_t)8 * 11 * 65536 * 4 <= (size_t)NB * SEQ * D * 4, "d_out scratch");

constexpr int LDS_BYTES = 147456, LDS_MISC = 131072;

struct Args {
    const float* in[28]; float* out; unsigned char* ws; int ph_lo, ph_hi;
};

#define GAS __attribute__((address_space(1)))
typedef const GAS float* gcf;
DI gcf INP(int i) { asm volatile("" : "+s"(i)); return ((const gcf*)__builtin_amdgcn_kernarg_segment_ptr())[i]; }
DI unsigned pk_bf16(float lo, float hi) { f32x2_t v = {lo, hi}; bf16x2_t b = __builtin_convertvector(v, bf16x2_t); return __builtin_bit_cast(unsigned, b); }
DI float bf_lo(unsigned u) { return __uint_as_float(u << 16); }
DI float bf_hi(unsigned u) { return __uint_as_float(u & 0xffff0000u); }
DI int row_pos(int row) { const int i = row % LROW; return i > NFRONT ? i - NFRONT : 0; }
DI int permP(int d) { return d < 16 ? ((d & 1) ? (d >> 1) + 8 : (d >> 1)) : d; }
DI int permM(int d) { return (d & 1) ? (d >> 1) + 32 : (d >> 1); }
DI float wave_sum(float v) {
#pragma unroll
    for (int o = 1; o < 64; o <<= 1) v += __shfl_xor(v, o);
    return v;
}
DI void rope8(f32x4& v0, f32x4& v1, const float2* tab) {
    const float2 t0 = tab[0], t1 = tab[1], t2 = tab[2], t3 = tab[3];
    f32x4 a = v0, b = v1;
    v0[0] = a[0] * t0.x - a[1] * t0.y; v0[1] = a[1] * t0.x + a[0] * t0.y;
    v0[2] = a[2] * t1.x - a[3] * t1.y; v0[3] = a[3] * t1.x + a[2] * t1.y;
    v1[0] = b[0] * t2.x - b[1] * t2.y; v1[1] = b[1] * t2.x + b[0] * t2.y;
    v1[2] = b[2] * t3.x - b[3] * t3.y; v1[3] = b[3] * t3.x + b[2] * t3.y;
}
DI u32x4 pack8(const f32x4& a, const f32x4& b) { u32x4 w; w.x = pk_bf16(a[0], a[1]); w.y = pk_bf16(a[2], a[3]); w.z = pk_bf16(b[0], b[1]); w.w = pk_bf16(b[2], b[3]); return w; }

#define EPI_ROW(ai, m) (u.pm * 256 + (ai) * 128 + wr * 64 + (m) * 16 + fr)
typedef const f32x4 (&AccRef)[2][2][4][2];

struct EpiSwiglu {
    static constexpr bool PERM = true, AFTER_DRAIN = false;
    unsigned char* ws; int ssq_idx;
    DI void operator()(AccRef acc, const pg8::Unit& u, int wr, int wc, int fr, int fq) const {
        bf16_t* O = (bf16_t*)(ws + WS_ACT); const float* ssq = (const float*)(ws + WS_SSQ) + (size_t)ssq_idx * R;
        const int f0 = u.pn * 128 + wc * 32 + fq * 8;
#pragma unroll
        for (int ai = 0; ai < 2; ++ai)
#pragma unroll
            for (int m = 0; m < 4; ++m) {
                const int row = EPI_ROW(ai, m); asm volatile("" ::: "memory");
                const float rstd = rsqrtf(ssq[row] * (1.0f / D) + EPS);
                f32x4 o[2];
#pragma unroll
                for (int n = 0; n < 2; ++n) {
                    const f32x4 g = acc[ai][0][m][n] * rstd, up = acc[ai][1][m][n] * rstd;
#pragma unroll
                    for (int e = 0; e < 4; ++e) o[n][e] = g[e] * __builtin_amdgcn_rcpf(1.0f + __builtin_amdgcn_exp2f(-g[e] * LOG2E)) * up[e];
                }
                *(u32x4*)(O + (size_t)row * FF + f0) = pack8(o[0], o[1]);
            }
    }
};

struct EpiResid {
    static constexpr bool PERM = true, AFTER_DRAIN = false;
    unsigned char* ws; int ssq_idx; int has_bias; float alpha;
    DI void operator()(AccRef acc, const pg8::Unit& u, int wr, int wc, int fr, int fq) const {
        float* h = (float*)(ws + WS_H); bf16_t* hb = (bf16_t*)(ws + WS_HB); float* ssq_out = (float*)(ws + WS_SSQ) + (size_t)ssq_idx * R; gcf bias = has_bias ? INP(22) : nullptr;
#pragma unroll
        for (int ai = 0; ai < 2; ++ai)
#pragma unroll
            for (int m = 0; m < 4; ++m) {
                const int row = EPI_ROW(ai, m); if (m == 0) asm volatile("" ::: "memory");
                float ss = 0.f;
#pragma unroll
                for (int bj = 0; bj < 2; ++bj) {
                    const int c = u.pn * 256 + bj * 128 + wc * 32 + fq * 8;
                    float* hp = h + (size_t)row * D + c;
                    f32x4 h0 = __builtin_nontemporal_load((const f32x4*)hp), h1 = __builtin_nontemporal_load((const f32x4*)(hp + 4));
                    h0 += acc[ai][bj][m][0] * alpha; h1 += acc[ai][bj][m][1] * alpha;
                    if (bias) { h0 += *(const GAS f32x4*)(bias + c); h1 += *(const GAS f32x4*)(bias + c + 4); }
                    __builtin_nontemporal_store(h0, (f32x4*)hp); __builtin_nontemporal_store(h1, (f32x4*)(hp + 4));
                    *(u32x4*)(hb + (size_t)row * D + c) = pack8(h0, h1);
                    ss += (h0[0] * h0[0] + h0[1] * h0[1]) + (h0[2] * h0[2] + h0[3] * h0[3]) + (h1[0] * h1[0] + h1[1] * h1[1]) + (h1[2] * h1[2] + h1[3] * h1[3]);
                }
                ss += __shfl_xor(ss, 16); ss += __shfl_xor(ss, 32);
                if (fq == 0) atomicAdd(ssq_out + row, ss);
            }
    }
};

struct EpiPartial {
    static constexpr bool PERM = true, AFTER_DRAIN = false;
    unsigned char* outb; int e, sl;
    DI void operator()(AccRef acc, const pg8::Unit& u, int wr, int wc, int fr, int fq) const {
        float* sp = (float*)(outb + OUT_SPLIT) + ((size_t)e * 11 + sl) * 65536;
#pragma unroll
        for (int ai = 0; ai < 2; ++ai)
#pragma unroll
            for (int m = 0; m < 4; ++m) {
                const int rl = ai * 128 + wr * 64 + m * 16 + fr;
#pragma unroll
                for (int bj = 0; bj < 2; ++bj) {
                    float* p = sp + rl * 256 + bj * 128 + wc * 32 + fq * 8;
                    *(f32x4*)p = acc[ai][bj][m][0]; *(f32x4*)(p + 4) = acc[ai][bj][m][1];
                }
            }
    }
};

struct EpiWin {
    static constexpr bool PERM = true, AFTER_DRAIN = false;
    unsigned char* ws; float qscale;
    DI void operator()(AccRef acc, const pg8::Unit& u, int wr, int wc, int fr, int fq) const {
        const float* ssq = (const float*)(ws + WS_SSQ) + (size_t)1 * R; float* ssq_cq = (float*)(ws + WS_SSQ) + (size_t)7 * R; float* ssq_ckv = (float*)(ws + WS_SSQ) + (size_t)8 * R;
        bf16_t *QA = (bf16_t*)(ws + WS_QA), *KA = (bf16_t*)(ws + WS_KA), *VA = (bf16_t*)(ws + WS_VA), *CQ = (bf16_t*)(ws + WS_CQ), *CKV = (bf16_t*)(ws + WS_CKV), *KM = (bf16_t*)(ws + WS_KM);
        const float2* tabP = (const float2*)(ws + WS_TABP); const float2* tabM = (const float2*)(ws + WS_TABM);
        const int pn = u.pn;
#pragma unroll
        for (int ai = 0; ai < 2; ++ai)
#pragma unroll
            for (int m = 0; m < 4; ++m) {
                const int row = EPI_ROW(ai, m); asm volatile("" ::: "memory");
                const int pos = row_pos(row);
                const float rstd = rsqrtf(ssq[row] * (1.0f / D) + EPS);
                float ss = 0.f;
#pragma unroll
                for (int bj = 0; bj < 2; ++bj) {
                    const int cl = bj * 128 + wc * 32 + fq * 8;
                    f32x4 v0 = acc[ai][bj][m][0] * rstd, v1 = acc[ai][bj][m][1] * rstd;
                    if (pn < 4) {
                        if ((cl & 63) < 16) rope8(v0, v1, tabP + pos * 8 + ((cl & 63) >> 1));
                        if (pn < 2) { v0 *= qscale; v1 *= qscale; }
                        bf16_t* dst = (pn < 2 ? QA : KA) + (size_t)row * 512 + (pn & 1) * 256 + cl;
                        *(u32x4*)dst = pack8(v0, v1);
                    } else if (pn < 6) {
                        *(u32x4*)(VA + (size_t)row * 512 + (pn - 4) * 256 + cl) = pack8(v0, v1);
                    } else if (pn < 8) {
                        *(u32x4*)((pn == 6 ? CQ : CKV) + (size_t)row * 256 + cl) = pack8(v0, v1);
                        ss += (v0[0] * v0[0] + v0[1] * v0[1]) + (v0[2] * v0[2] + v0[3] * v0[3]) + (v1[0] * v1[0] + v1[1] * v1[1]) + (v1[2] * v1[2] + v1[3] * v1[3]);
                    } else if (cl < 64) {
                        rope8(v0, v1, tabM + pos * 32 + (cl >> 1));
                        const u32x4 w = pack8(v0, v1);
#pragma unroll
                        for (int hh = 0; hh < 4; ++hh) *(u32x4*)(KM + (size_t)row * 768 + hh * 192 + 128 + cl) = w;
                    }
                }
                if (pn == 6 || pn == 7) {
                    ss += __shfl_xor(ss, 16); ss += __shfl_xor(ss, 32);
                    if (fq == 0) atomicAdd((pn == 6 ? ssq_cq : ssq_ckv) + row, ss);
                }
            }
    }
};

struct EpiUq {
    static constexpr bool PERM = true, AFTER_DRAIN = false;
    unsigned char* ws; float qscale;
    DI void operator()(AccRef acc, const pg8::Unit& u, int wr, int wc, int fr, int fq) const {
        const float* ssq_cq = (const float*)(ws + WS_SSQ) + (size_t)7 * R; bf16_t* QM = (bf16_t*)(ws + WS_QM); const float2* tabM = (const float2*)(ws + WS_TABM);
#pragma unroll
        for (int ai = 0; ai < 2; ++ai)
#pragma unroll
            for (int m = 0; m < 4; ++m) {
                const int row = EPI_ROW(ai, m); asm volatile("" ::: "memory");
                const int pos = row_pos(row);
                const float rstd = rsqrtf(ssq_cq[row] * (1.0f / 256) + EPS);
#pragma unroll
                for (int bj = 0; bj < 2; ++bj) {
                    const int c = u.pn * 256 + bj * 128 + wc * 32 + fq * 8;
                    const int d = c % 192;
                    f32x4 v0 = acc[ai][bj][m][0] * rstd, v1 = acc[ai][bj][m][1] * rstd;
                    if (d >= 128) rope8(v0, v1, tabM + pos * 32 + ((d - 128) >> 1));
                    v0 *= qscale; v1 *= qscale;
                    *(u32x4*)(QM + (size_t)row * 768 + c) = pack8(v0, v1);
                }
            }
    }
};

struct EpiUkv {
    static constexpr bool PERM = true, AFTER_DRAIN = false;
    unsigned char* ws; unsigned char* outb;
    DI void operator()(AccRef acc, const pg8::Unit& u, int wr, int wc, int fr, int fq) const {
        const float* ssq_ckv = (const float*)(ws + WS_SSQ) + (size_t)8 * R; bf16_t* KM = (bf16_t*)(ws + WS_KM); bf16_t* VM = (bf16_t*)(outb + OUT_VM);
#pragma unroll
        for (int ai = 0; ai < 2; ++ai)
#pragma unroll
            for (int m = 0; m < 4; ++m) {
                const int row = EPI_ROW(ai, m); asm volatile("" ::: "memory");
                const float rstd = rsqrtf(ssq_ckv[row] * (1.0f / 256) + EPS);
                const int cl = wc * 32 + fq * 8;
                *(u32x4*)(KM + (size_t)row * 768 + u.pn * 192 + cl) = pack8(acc[ai][0][m][0] * rstd, acc[ai][0][m][1] * rstd);
                *(u32x4*)(VM + (size_t)row * 512 + u.pn * 128 + cl) = pack8(acc[ai][1][m][0] * rstd, acc[ai][1][m][1] * rstd);
            }
    }
};

struct EpiQkvS {
    static constexpr bool PERM = true, AFTER_DRAIN = false;
    unsigned char* ws; float qscale;
    DI void operator()(AccRef acc, const pg8::Unit& u, int wr, int wc, int fr, int fq) const {
        const float* ssq = (const float*)(ws + WS_SSQ) + (size_t)4 * R; const float* bias = (const float*)(ws + WS_BQKV); bf16_t *QS = (bf16_t*)(ws + WS_QS), *KS = (bf16_t*)(ws + WS_KS), *VS = (bf16_t*)(ws + WS_VS); const float2* tabP = (const float2*)(ws + WS_TABP);
        const int pn = u.pn;
#pragma unroll
        for (int ai = 0; ai < 2; ++ai)
#pragma unroll
            for (int m = 0; m < 4; ++m) {
                const int row = EPI_ROW(ai, m); asm volatile("" ::: "memory");
                const int pos = row_pos(row);
                const float rstd = rsqrtf(ssq[row] * (1.0f / D) + EPS);
#pragma unroll
                for (int bj = 0; bj < 2; ++bj) {
                    const int cl = bj * 128 + wc * 32 + fq * 8, c = pn * 256 + cl;
                    f32x4 v0 = acc[ai][bj][m][0] * rstd + *(const f32x4*)(bias + c), v1 = acc[ai][bj][m][1] * rstd + *(const f32x4*)(bias + c + 4);
                    const bool isv = (pn == 4 && bj == 1);
                    if (!isv && (cl & 63) < 16) rope8(v0, v1, tabP + pos * 8 + ((cl & 63) >> 1));
                    if (pn < 4) { v0 *= qscale; v1 *= qscale; *(u32x4*)(QS + (size_t)row * 1024 + c) = pack8(v0, v1); }
                    else if (bj == 0) *(u32x4*)(KS + (size_t)row * 128 + cl) = pack8(v0, v1);
                    else *(u32x4*)(VS + (size_t)row * 128 + (cl - 128)) = pack8(v0, v1);
                }
            }
    }
};
#define MFMA32(a, b, c) __builtin_amdgcn_mfma_f32_32x32x16_bf16((a), (b), (c), 0, 0, 0)
typedef short v4i16_t __attribute__((ext_vector_type(4)));
DI s16x4 tr_read(const LAS unsigned char* p) { return __builtin_bit_cast(s16x4, __builtin_amdgcn_ds_read_tr16_b64_v4i16((LAS v4i16_t*)p)); }
DI float xhalf_max(float v) { auto rr = __builtin_amdgcn_permlane32_swap(__float_as_uint(v), __float_as_uint(v), false, false); return fmaxf(__uint_as_float(rr[0]), __uint_as_float(rr[1])); }
DI float xhalf_sum(float v) { auto rr = __builtin_amdgcn_permlane32_swap(__float_as_uint(v), __float_as_uint(v), false, false); return __uint_as_float(rr[0]) + __uint_as_float(rr[1]); }
DI float max3f(float a, float b, float c) { float r; asm("v_max3_f32 %0, %1, %2, %3" : "=v"(r) : "v"(a), "v"(b), "v"(c)); return r; }
DI int crow(int i, int h) { return (i & 3) + 8 * (i >> 2) + 4 * h; }

template <int DQK, int DV, int KP, int VP, bool MASKED, class MaskF>
DI void attn_tile(const LAS unsigned char* Ks, const LAS unsigned char* Vs, const bf16x8 (&qf)[DQK / 16], f32x16 (&o)[DV / 32], float& m, float& l, int lane, const MaskF& allowed) {
    const int r = lane & 31, h = lane >> 5;
    f32x16 s0, s1;
#pragma unroll
    for (int i = 0; i < 16; ++i) { s0[i] = 0.f; s1[i] = 0.f; }
    const LAS unsigned char* kb = Ks + r * KP + h * 16;
    __builtin_amdgcn_s_setprio(1);
#pragma unroll
    for (int ks = 0; ks < DQK / 16; ++ks) {
        if ((ks & 3) == 0 && ks) asm volatile("" ::: "memory");
        const bf16x8 a0 = *(const LAS bf16x8*)(kb + ks * 32);
        const bf16x8 a1 = *(const LAS bf16x8*)(kb + 32 * KP + ks * 32);
        s0 = MFMA32(a0, qf[ks], s0); s1 = MFMA32(a1, qf[ks], s1);
    }
    __builtin_amdgcn_s_setprio(0);
    constexpr bool PFV = (DQK <= 64);
    const int q4 = (lane & 15) >> 2, p4 = lane & 3, blk = (lane >> 4) & 1;
    const LAS unsigned char* vb = Vs + (4 * h + q4) * VP + (16 * blk + 4 * p4) * 2;
    bf16x8 vcur[DV / 32];
    if (PFV) {
#pragma unroll
        for (int dt = 0; dt < DV / 32; ++dt) { const s16x4 lo = tr_read(vb + dt * 64), hi = tr_read(vb + 8 * VP + dt * 64); vcur[dt] = __builtin_shufflevector(lo, hi, 0, 1, 2, 3, 4, 5, 6, 7); }
    }
    asm volatile("" ::: "memory");
    if (MASKED) {
#pragma unroll
        for (int i = 0; i < 16; ++i) { const int k0 = crow(i, h); if (!allowed(k0)) s0[i] = NEGBIG; if (!allowed(32 + k0)) s1[i] = NEGBIG; }
    }
    float mxa = max3f(s0[0], s0[1], s1[0]), mxb = max3f(s0[2], s0[3], s1[1]);
    mxa = max3f(mxa, s1[2], s1[3]);
#pragma unroll
    for (int i = 4; i < 16; i += 4) { mxa = max3f(mxa, s0[i], s0[i + 1]); mxb = max3f(mxb, s0[i + 2], s0[i + 3]); mxa = max3f(mxa, s1[i], s1[i + 1]); mxb = max3f(mxb, s1[i + 2], s1[i + 3]); }
    const float mx = xhalf_max(fmaxf(mxa, mxb));
    const float mn = (mx > m + 8.0f) ? mx : m;
    if (__builtin_amdgcn_ballot_w64(mn != m) != 0ull) {
        const float alpha = __builtin_amdgcn_exp2f(m - mn);
        l *= alpha;
#pragma unroll
        for (int dt = 0; dt < DV / 32; ++dt) o[dt] *= alpha;
        m = mn;
    }
    float ps0 = 0.f, ps1 = 0.f;
#pragma unroll
    for (int i = 0; i < 16; ++i) { s0[i] = __builtin_amdgcn_exp2f(s0[i] - mn); s1[i] = __builtin_amdgcn_exp2f(s1[i] - mn); ps0 += s0[i]; ps1 += s1[i]; }
    l += ps0 + ps1;
    bf16x8 pb[4];
#pragma unroll
    for (int s = 0; s < 2; ++s) {
        u32x4 w0, w1;
        w0.x = pk_bf16(s0[8 * s + 0], s0[8 * s + 1]); w0.y = pk_bf16(s0[8 * s + 2], s0[8 * s + 3]); w0.z = pk_bf16(s0[8 * s + 4], s0[8 * s + 5]); w0.w = pk_bf16(s0[8 * s + 6], s0[8 * s + 7]);
        w1.x = pk_bf16(s1[8 * s + 0], s1[8 * s + 1]); w1.y = pk_bf16(s1[8 * s + 2], s1[8 * s + 3]); w1.z = pk_bf16(s1[8 * s + 4], s1[8 * s + 5]); w1.w = pk_bf16(s1[8 * s + 6], s1[8 * s + 7]);
        pb[s] = __builtin_bit_cast(bf16x8, w0); pb[2 + s] = __builtin_bit_cast(bf16x8, w1);
    }
    __builtin_amdgcn_s_setprio(1);
#pragma unroll
    for (int g = 0; g < 4; ++g) {
        bf16x8 vnext[DV / 32];
        if (PFV) {
            if (g < 3) {
#pragma unroll
                for (int dt = 0; dt < DV / 32; ++dt) { const s16x4 lo = tr_read(vb + (16 * (g + 1)) * VP + dt * 64), hi = tr_read(vb + (16 * (g + 1) + 8) * VP + dt * 64); vnext[dt] = __builtin_shufflevector(lo, hi, 0, 1, 2, 3, 4, 5, 6, 7); }
            }
            asm volatile("" ::: "memory");
        } else {
            asm volatile("" ::: "memory");
#pragma unroll
            for (int dt = 0; dt < DV / 32; ++dt) { const s16x4 lo = tr_read(vb + (16 * g) * VP + dt * 64), hi = tr_read(vb + (16 * g + 8) * VP + dt * 64); vcur[dt] = __builtin_shufflevector(lo, hi, 0, 1, 2, 3, 4, 5, 6, 7); }
        }
#pragma unroll
        for (int dt = 0; dt < DV / 32; ++dt) o[dt] = MFMA32(vcur[dt], pb[g], o[dt]);
        if (PFV && g < 3) {
#pragma unroll
            for (int dt = 0; dt < DV / 32; ++dt) vcur[dt] = vnext[dt];
        }
    }
    __builtin_amdgcn_s_setprio(0);
}

template <int NCH, int N>
DI void tile_load(u32x4 (&reg)[N], const bf16_t* src  , int pitch, int tid) {
#pragma unroll
    for (int i = 0; i < N; ++i) { const int c = tid + 512 * i, key = c / NCH, part = c % NCH; reg[i] = *(const u32x4*)(src + (size_t)key * pitch + part * 8); }
}
template <int NCH, int N, int PB>
DI void tile_store(const u32x4 (&reg)[N], LAS unsigned char* buf, int tid) {
#pragma unroll
    for (int i = 0; i < N; ++i) { const int c = tid + 512 * i, key = c / NCH, part = c % NCH; *(LAS u32x4*)(buf + key * PB + part * 16) = reg[i]; }
}

template <int DQK, int DV>
DI void causal_attn(LAS unsigned char* lds, const bf16_t* Qp, int qpitch, const bf16_t* Kp, int kpitch, const bf16_t* Vp, int vpitch, int q0, f32x16 (&o)[DV / 32], int tid) {
    constexpr int KP = DQK * 2 + 16, VP = DV * 2 + 64, KBUF = 64 * KP, VBUF = 64 * VP;
    constexpr int KCH = DQK / 8, VCH = DV / 8, KN = 64 * KCH / 512, VN = 64 * VCH / 512;
    LAS unsigned char* Kb = lds; LAS unsigned char* Vb = lds + 2 * KBUF;
    const int lane = tid & 63, w = tid >> 6, r = lane & 31, h = lane >> 5, qw = q0 + 32 * w;
    const int qtrue = qw + r, qrow = qtrue < 0 ? 0 : (qtrue > LROW - 1 ? LROW - 1 : qtrue);
    bf16x8 qf[DQK / 16];
#pragma unroll
    for (int ks = 0; ks < DQK / 16; ++ks) qf[ks] = *(const bf16x8*)(Qp + (size_t)qrow * qpitch + ks * 16 + h * 8);
    float m = NEGBIG, l = 0.f;
#pragma unroll
    for (int dt = 0; dt < DV / 32; ++dt)
#pragma unroll
        for (int i = 0; i < 16; ++i) o[dt][i] = 0.f;
    const int qlast = (q0 + 255 > LROW - 1) ? LROW - 1 : q0 + 255, ktend = qlast >> 6;
    const bool wactive = (qw + 31 >= NFRONT);
    u32x4 kreg[KN], vreg[VN];
    tile_load<KCH, KN>(kreg, Kp + (size_t)64 * kpitch, kpitch, tid); tile_load<VCH, VN>(vreg, Vp + (size_t)64 * vpitch, vpitch, tid);
    tile_store<KCH, KN, KP>(kreg, Kb, tid); tile_store<VCH, VN, VP>(vreg, Vb, tid);
    __syncthreads();
    int cur = 0;
    for (int kt = 1; kt <= ktend; ++kt) {
        if (kt < ktend) { tile_load<KCH, KN>(kreg, Kp + (size_t)(64 * (kt + 1)) * kpitch, kpitch, tid); tile_load<VCH, VN>(vreg, Vp + (size_t)(64 * (kt + 1)) * vpitch, vpitch, tid); }
        if (wactive && 64 * kt <= qw + 31) {
            const LAS unsigned char* Ks = Kb + cur * KBUF; const LAS unsigned char* Vs = Vb + cur * VBUF;
            const int k64 = 64 * kt;
            auto allowed = [&](int slot) { const int kg = k64 + slot; return kg <= qtrue && kg >= NFRONT; };
            if (k64 + 63 > qw || kt == 1) attn_tile<DQK, DV, KP, VP, true>(Ks, Vs, qf, o, m, l, lane, allowed);
            else attn_tile<DQK, DV, KP, VP, false>(Ks, Vs, qf, o, m, l, lane, allowed);
        }
        if (kt < ktend) { tile_store<KCH, KN, KP>(kreg, Kb + (cur ^ 1) * KBUF, tid); tile_store<VCH, VN, VP>(vreg, Vb + (cur ^ 1) * VBUF, tid); }
        __syncthreads();
        cur ^= 1;
    }
    l = xhalf_sum(l);
    const float inv = 1.0f / l;
#pragma unroll
    for (int dt = 0; dt < DV / 32; ++dt) o[dt] *= inv;
}

template <int NDT>
DI void store_oT(bf16_t* dst, const f32x16 (&o)[NDT], int h, bool zero) {
#pragma unroll
    for (int dt = 0; dt < NDT; ++dt)
#pragma unroll
        for (int g = 0; g < 4; ++g) {
            u32x2 w; w.x = pk_bf16(o[dt][4 * g], o[dt][4 * g + 1]); w.y = pk_bf16(o[dt][4 * g + 2], o[dt][4 * g + 3]);
            if (zero) { w.x = 0u; w.y = 0u; }
            *(u32x2*)(dst + 32 * dt + 8 * g + 4 * h) = w;
        }
}

struct AttnL0 { const bf16_t *QA, *KA, *VA, *QM, *KM, *VM; bf16_t* OAB; gcf subln; float lam; };

DI void attn_unit_diff(LAS unsigned char* lds, const AttnL0& A, int b, int hh, int t, int tid) {
    const int lane = tid & 63, w = tid >> 6, r = lane & 31, h = lane >> 5, q0 = 256 * t - 128, qtrue = q0 + 32 * w + r;
    const size_t rb = (size_t)b * LROW;
    const bf16_t* Vp = A.VA + rb * 512 + hh * 128;
    LAS unsigned* o1s = (LAS unsigned*)(lds + 61440) + tid;
    {
        f32x16 o1[4];
        causal_attn<64, 128>(lds, A.QA + rb * 512 + hh * 128 + 64, 512, A.KA + rb * 512 + hh * 128 + 64, 512, Vp, 512, q0, o1, tid);
#pragma unroll
        for (int dt = 0; dt < 4; ++dt)
#pragma unroll
            for (int i = 0; i < 8; ++i) o1s[(dt * 8 + i) * 512] = pk_bf16(o1[dt][2 * i], o1[dt][2 * i + 1]);
    }
    f32x16 o[4];
    causal_attn<64, 128>(lds, A.QA + rb * 512 + hh * 128, 512, A.KA + rb * 512 + hh * 128, 512, Vp, 512, q0, o, tid);
    float ss = 0.f;
#pragma unroll
    for (int dt = 0; dt < 4; ++dt)
#pragma unroll
        for (int i = 0; i < 8; ++i) {
            const unsigned pw = o1s[(dt * 8 + i) * 512];
            const float x0 = o[dt][2 * i] - A.lam * bf_lo(pw), x1 = o[dt][2 * i + 1] - A.lam * bf_hi(pw);
            o[dt][2 * i] = x0; o[dt][2 * i + 1] = x1; ss += x0 * x0 + x1 * x1;
        }
    ss = xhalf_sum(ss);
    const float rs = rsqrtf(ss * (1.0f / 128) + 1e-5f) * 0.8f;
#pragma unroll
    for (int dt = 0; dt < 4; ++dt)
#pragma unroll
        for (int g = 0; g < 4; ++g) { const f32x4 sg = *(const GAS f32x4*)(A.subln + 32 * dt + 8 * g + 4 * h);
#pragma unroll
            for (int e = 0; e < 4; ++e) o[dt][4 * g + e] *= rs * sg[e]; }
    if (qtrue >= 0 && qtrue < LROW) store_oT<4>(A.OAB + (rb + qtrue) * 1024 + hh * 128, o, h, qtrue < NFRONT);
}
DI void attn_unit_mla(LAS unsigned char* lds, const AttnL0& A, int b, int hh, int t, int tid) {
    const int lane = tid & 63, w = tid >> 6, r = lane & 31, h = lane >> 5, q0 = 256 * t - 128, qtrue = q0 + 32 * w + r;
    const size_t rb = (size_t)b * LROW;
    f32x16 o[4];
    causal_attn<192, 128>(lds, A.QM + rb * 768 + hh * 192, 768, A.KM + rb * 768 + hh * 192, 768, A.VM + rb * 512 + hh * 128, 512, q0, o, tid);
    if (qtrue >= 0 && qtrue < LROW) store_oT<4>(A.OAB + (rb + qtrue) * 1024 + 512 + hh * 128, o, h, qtrue < NFRONT);
}

struct AttnL1 { const bf16_t *QS, *KS, *VS; bf16_t* OS; gcf sinks; };
DI void attn_unit_swa(LAS unsigned char* lds, const AttnL1& A, int b, int kvh, int n, int tid) {
    constexpr int KP = 144, VP = 192, NROW = 320;
    LAS unsigned char* Kb = lds; LAS unsigned char* Vb = lds + NROW * KP;
    const size_t rb = (size_t)b * LROW;
    for (int c = tid; c < NROW * 8; c += 512) {
        const int j = c >> 3, part = c & 7;
        int gr = (j < 256) ? 128 * (n - 1) + j : ((j < 272) ? NFRONT + (j - 256) : -1);
        u32x4 kv = {0u, 0u, 0u, 0u}, vv = {0u, 0u, 0u, 0u};
        if (gr >= 0) { kv = *(const u32x4*)(A.KS + (rb + gr) * 128 + kvh * 64 + part * 8); vv = *(const u32x4*)(A.VS + (rb + gr) * 128 + kvh * 64 + part * 8); }
        *(LAS u32x4*)(Kb + j * KP + part * 16) = kv; *(LAS u32x4*)(Vb + j * VP + part * 16) = vv;
    }
    __syncthreads();
    const int lane = tid & 63, g = tid >> 6, r = lane & 31, h = lane >> 5, head = kvh * 8 + g;
    const float sink = A.sinks[head] * LOG2E;
    for (int j = 0; j < 4; ++j) {
        const int qtrue = 128 * n + 32 * j + r;
        bf16x8 qf[4];
#pragma unroll
        for (int ks = 0; ks < 4; ++ks) qf[ks] = *(const bf16x8*)(A.QS + (rb + qtrue) * 1024 + head * 64 + ks * 16 + h * 8);
        float m = sink, l = (h == 0) ? 1.0f : 0.0f;
        f32x16 o[2];
#pragma unroll
        for (int dt = 0; dt < 2; ++dt)
#pragma unroll
            for (int i = 0; i < 16; ++i) o[dt][i] = 0.f;
        const int tb0 = (j < 2) ? 0 : 1;
        for (int tb = tb0; tb < tb0 + 3; ++tb) {
            const int kbase = 128 * (n - 1) + 64 * tb;
            auto allowed = [&](int slot) { const int kg = kbase + slot; return kg <= qtrue && kg >= NFRONT && (kg < 128 || qtrue - kg < 128); };
            attn_tile<64, 64, KP, VP, true>(Kb + 64 * tb * KP, Vb + 64 * tb * VP, qf, o, m, l, lane, allowed);
        }
        if (n >= 2) {
            auto allowed = [&](int slot) { return slot < 16; };
            attn_tile<64, 64, KP, VP, true>(Kb + 256 * KP, Vb + 256 * VP, qf, o, m, l, lane, allowed);
        }
        l = xhalf_sum(l);
        const float inv = 1.0f / l;
#pragma unroll
        for (int dt = 0; dt < 2; ++dt) o[dt] *= inv;
        store_oT<2>(A.OS + (rb + qtrue) * 1024 + head * 64, o, h, qtrue < NFRONT);
    }
    __syncthreads();
}
#define XB_TMO      128
#define XB_XCNT(j)  (256  + 64 * (j))
#define XB_XSUB(j)  (1280 + 64 * (j))
#define XB_XGEN(j)  (2304 + 64 * (j))
#define XB_TOP      3328
#define XB_TOPGEN   3392
#define XCD_BAR_WORDS 3456
#define XB_SPIN_CAP (1u << 18)

__device__ __forceinline__ unsigned xb_ld(unsigned* p)              { return __hip_atomic_load(p, __ATOMIC_RELAXED, __HIP_MEMORY_SCOPE_AGENT); }
__device__ __forceinline__ unsigned xb_add(unsigned* p, unsigned v) { return __hip_atomic_fetch_add(p, v, __ATOMIC_RELAXED, __HIP_MEMORY_SCOPE_AGENT); }
__device__ __forceinline__ unsigned xb_xcc_id() { return (unsigned)__builtin_amdgcn_s_getreg((3 << 11) | 20) & 0xFu; }
#define XB_SPIN(cond, bar) do { unsigned _sp = 0; while (cond) { __builtin_amdgcn_s_sleep(1); \
    if ((++_sp & 255u) == 0u) { if (xb_ld(&(bar)[XB_TMO])) break; if (_sp > XB_SPIN_CAP) { atomicAdd(&(bar)[XB_TMO], 1u); break; } } } } while (0)

struct XcdBarrier {
    unsigned* bar; unsigned x;
    volatile LAS unsigned* st;
};

__device__ __forceinline__ XcdBarrier xcd_barrier_post(unsigned* bar, volatile LAS unsigned* st) {
    XcdBarrier b; b.bar = bar; b.x = xb_xcc_id(); b.st = st;
    if (threadIdx.x == 0) (void)xb_add(&bar[XB_XCNT(b.x)], 1u);
    return b;
}
__device__ __forceinline__ void xcd_barrier_complete(unsigned* bar, unsigned x, unsigned& nloc, unsigned& nx) {
    const unsigned G = gridDim.x * gridDim.y * gridDim.z;
    unsigned sum, cnt, mine, sp = 0u;
    for (;;) {
        sum = 0u; cnt = 0u; mine = 0u;
#pragma unroll
        for (unsigned j = 0; j < 16; ++j) { const unsigned c = xb_ld(&bar[XB_XCNT(j)]); sum += c; cnt += (c > 0u) ? 1u : 0u; mine = (j == x) ? c : mine; }
        if (sum == G) break;
        __builtin_amdgcn_s_sleep(1);
        if ((++sp & 255u) == 0u) { if (xb_ld(&bar[XB_TMO])) break; if (sp > XB_SPIN_CAP) { atomicAdd(&bar[XB_TMO], 1u); break; } }
    }
    nloc = mine > 0u ? mine : 1u; nx = cnt > 0u ? cnt : 1u;
}

__device__ __forceinline__ void xcd_barrier(const XcdBarrier& b) {
    asm volatile("s_waitcnt vmcnt(0)" ::: "memory");
    __syncthreads();
    if (threadIdx.x == 0) {
        unsigned* bar = b.bar;
        __builtin_amdgcn_s_waitcnt(0);
        unsigned nloc = b.st[0], nx = b.st[1];
        if (nloc == 0u) { xcd_barrier_complete(bar, b.x, nloc, nx); b.st[0] = nloc; b.st[1] = nx; }
        const unsigned old = xb_add(&bar[XB_XSUB(b.x)], 1u);
        const unsigned gen = old / nloc;
        if (old + 1u == (gen + 1u) * nloc) {
            __builtin_amdgcn_fence(__ATOMIC_RELEASE, "agent");
            asm volatile("s_waitcnt vmcnt(0)" ::: "memory");
            const unsigned og = xb_add(&bar[XB_TOP], 1u);
            const unsigned tg = og / nx;
            if (og + 1u == (tg + 1u) * nx) xb_add(&bar[XB_TOPGEN], 1u);
            else XB_SPIN(xb_ld(&bar[XB_TOPGEN]) == tg, bar);
            __builtin_amdgcn_fence(__ATOMIC_ACQUIRE, "agent");
            xb_add(&bar[XB_XGEN(b.x)], 1u);
            asm volatile("s_waitcnt vmcnt(0)" ::: "memory");
        } else {
            XB_SPIN(xb_ld(&bar[XB_XGEN(b.x)]) == gen, bar);
            __builtin_amdgcn_fence(__ATOMIC_ACQUIRE, "agent");
            asm volatile("s_waitcnt vmcnt(0)" ::: "memory");
        }
    }
    __syncthreads();
}

DI int srccol(int kind, int nd) {
    if (kind == 1) return 128 * (nd >> 8) + (nd & 127);
    if (kind == 2) { if (nd < 1024) return (nd & ~63) + permP(nd & 63); if (nd < 2048) return nd; if (nd < 2112) return 2048 + permM(nd - 2048); return -1; }
    if (kind == 3) { const int hh = nd / 192, d = nd % 192; return hh * 192 + (d < 128 ? d : 128 + permM(d - 128)); }
    if (kind == 4) { if (nd < 1152) return (nd & ~63) + permP(nd & 63); return nd; }
    return nd;
}
DI void wt_item(gcf W, int ldw, int nsrc, int Kdim, int k0, int n0, int kind, gcf gain, bf16_t* WT, LAS float* scr, int lane) {
    const int sbase = (kind == 1) ? 128 * (n0 >> 8) : n0;
    const int c4 = (lane & 31) * 4;
    const bool okc = sbase + c4 < nsrc;
    f32x4 v[16];
#pragma unroll
    for (int i = 0; i < 16; ++i) {
        const int kk = 2 * i + (lane >> 5);
        v[i] = (f32x4){0.f, 0.f, 0.f, 0.f};
        if (okc) v[i] = *(const GAS f32x4*)(W + (size_t)(k0 + kk) * ldw + sbase + c4);
    }
#pragma unroll
    for (int i = 0; i < 16; ++i) {
        const int kk = 2 * i + (lane >> 5);
        if (gain) v[i] *= gain[k0 + kk];
        *(LAS f32x4*)(scr + kk * 132 + c4) = v[i];
    }
    asm volatile("s_waitcnt lgkmcnt(0)" ::: "memory");
    const int kq = lane >> 4;
#pragma unroll
    for (int j = 0; j < 8; ++j) {
        const int n = (lane & 15) + 16 * j;
        const int sc = srccol(kind, n0 + n);
        u32x4 o = {0u, 0u, 0u, 0u};
        if (sc >= 0) { const LAS float* s = scr + (8 * kq) * 132 + (sc - sbase);
            o.x = pk_bf16(s[0 * 132], s[1 * 132]); o.y = pk_bf16(s[2 * 132], s[3 * 132]); o.z = pk_bf16(s[4 * 132], s[5 * 132]); o.w = pk_bf16(s[6 * 132], s[7 * 132]); }
        *(u32x4*)(WT + (size_t)(n0 + n) * Kdim + k0 + 8 * kq) = o;
    }
    asm volatile("s_waitcnt lgkmcnt(0)" ::: "memory");
}
constexpr int I_GU = 32 * 44, I_DN = 88 * 8, I_FFN = I_GU + I_DN, I_WIN = 32 * 18, I_UQ = 8 * 6, I_UKV = 8 * 8, I_WO = 32 * 8, I_QKV = 32 * 10;
constexpr int W_ITEMS_L0 = 2 * I_FFN + I_WIN + I_UQ + I_UKV + I_WO, W_ITEMS = W_ITEMS_L0 + 2 * I_FFN + I_QKV + I_WO;
DI void convert_weights(unsigned char* ws, LAS unsigned char* lds, int tid, int it_lo, int it_hi, int gw, int NGW) {
    const int lane = tid & 63, wave = tid >> 6;
    LAS float* scr = (LAS float*)(lds + wave * 16896);
    bf16_t* WB = (bf16_t*)(ws + WS_W);
    for (int it = it_lo + gw; it < it_hi; it += NGW) {
        int r = it, lyr = 0;
        if (r >= W_ITEMS_L0) { r -= W_ITEMS_L0; lyr = 1; }
        if (r < 2 * I_FFN) {
            const int f = r / I_FFN, fi = 2 * lyr + f; r %= I_FFN;
            if (r < I_GU) {
                const int kb = r / 44, n0 = (r % 44) * 128;
                gcf W = (((n0 & 255) < 128) ? (f ? INP(24) : INP(3)) : (f ? INP(25) : INP(4))) + (size_t)lyr * D * FF;
                wt_item(W, FF, FF, D, kb * 32, n0, 1, (f ? INP(23) : INP(2)) + lyr * D, WB + WOFF_FFN + (size_t)fi * (W_GU + W_DN), scr, lane);
            } else {
                r -= I_GU;
                wt_item((f ? INP(26) : INP(5)) + (size_t)lyr * FF * D, D, D, FF, (r / 8) * 32, (r % 8) * 128, 0, nullptr, WB + WOFF_FFN + (size_t)fi * (W_GU + W_DN) + W_GU, scr, lane);
            }
            continue;
        }
        r -= 2 * I_FFN;
        if (lyr == 0) {
            if (r < I_WIN) { wt_item(INP(7), 2112, 2112, D, (r / 18) * 32, (r % 18) * 128, 2, INP(6), WB + WOFF_WIN, scr, lane); continue; } r -= I_WIN;
            if (r < I_UQ) { wt_item(INP(14), 768, 768, 256, (r / 6) * 32, (r % 6) * 128, 3, INP(13), WB + WOFF_UQ, scr, lane); continue; } r -= I_UQ;
            if (r < I_UKV) { wt_item(INP(16), 1024, 1024, 256, (r / 8) * 32, (r % 8) * 128, 0, INP(15), WB + WOFF_UKV, scr, lane); continue; } r -= I_UKV;
            wt_item(INP(17), 1024, 1024, D, (r / 8) * 32, (r % 8) * 128, 0, nullptr, WB + WOFF_WO0, scr, lane);
        } else {
            if (r < I_QKV) { wt_item(INP(18), 1280, 1280, D, (r / 10) * 32, (r % 10) * 128, 4, INP(6) + D, WB + WOFF_QKV, scr, lane); continue; } r -= I_QKV;
            wt_item(INP(21), 1024, 1024, D, (r / 8) * 32, (r % 8) * 128, 0, nullptr, WB + WOFF_WO1, scr, lane);
        }
    }
}

DI void prologue(const Args& a, LAS unsigned char* lds, int tid) {
    const int lane = tid & 63, wave = tid >> 6;
    const int gt = blockIdx.x * 512 + tid, nthr = gridDim.x * 512;
    const int gw = blockIdx.x * 8 + wave, NGW = gridDim.x * 8;
    float* ssq = (float*)(a.ws + WS_SSQ);
    for (int i = gt; i < 8 * R; i += nthr) ssq[R + i] = 0.f;
    if (gt < 256) ((unsigned*)(a.ws + WS_CTL))[gt] = 0u;
    {
        float2* tabP = (float2*)(a.ws + WS_TABP); float2* tabM = (float2*)(a.ws + WS_TABM);
        for (int e = gt; e < NPOS * 40; e += nthr) {
            const int pos = e / 40, i = e % 40;
            const double ex = (i < 8) ? (double)(2 * i) / 16.0 : (double)(2 * (i - 8)) / 64.0;
            const double inv = exp2(-ex * 18.931568569324174);
            double rev = (double)pos * inv * 0.15915494309189535;
            rev -= floor(rev);
            const float f = (float)rev;
            const float2 cs = make_float2(__builtin_amdgcn_cosf(f), __builtin_amdgcn_sinf(f));
            if (i < 8) tabP[pos * 8 + i] = cs; else tabM[pos * 32 + (i - 8)] = cs;
        }
    }
    { float* bp = (float*)(a.ws + WS_BQKV); gcf bq = INP(19); for (int i = gt; i < NQKV; i += nthr) bp[i] = bq[srccol(4, i)]; }
    {
        float* H = (float*)(a.ws + WS_H); bf16_t* HB = (bf16_t*)(a.ws + WS_HB);
        for (int row = gw; row < R; row += NGW) {
            const int b = row / LROW, i = row % LROW;
            gcf src = (i < NFRONT) ? nullptr : (i < 128 ? INP(1) + (size_t)(i - NFRONT) * D : INP(0) + ((size_t)b * SEQ + (i - 128)) * D);
            float s = 0.f;
#pragma unroll
            for (int j = 0; j < 4; ++j) {
                f32x4 v = {0.f, 0.f, 0.f, 0.f};
                if (src) v = *(const GAS f32x4*)(src + 256 * j + 4 * lane);
                *(f32x4*)(H + (size_t)row * D + 256 * j + 4 * lane) = v;
                u32x2 w; w.x = pk_bf16(v[0], v[1]); w.y = pk_bf16(v[2], v[3]);
                *(u32x2*)(HB + (size_t)row * D + 256 * j + 4 * lane) = w;
                s += (v[0] * v[0] + v[1] * v[1]) + (v[2] * v[2] + v[3] * v[3]);
            }
            s = wave_sum(s);
            if (lane == 0) ssq[row] = s;
        }
    }
    convert_weights(a.ws, lds, tid, 0, W_ITEMS_L0, gw, NGW);
}

constexpr int NPH_ = 23;
__global__ void __launch_bounds__(512, 2) fwd(Args a) {
    extern __shared__ __attribute__((aligned(16))) unsigned char lds_raw[];
    LAS unsigned char* lds = (LAS unsigned char*)lds_raw;
    volatile LAS unsigned* misc = (volatile LAS unsigned*)(lds + LDS_MISC);
    cg::grid_group grid = cg::this_grid();
    volatile LAS unsigned* xst = (volatile LAS unsigned*)(lds + 147392);
    if (threadIdx.x == 0) { xst[0] = 0u; xst[1] = 0u; }
    __syncthreads();
    if (a.ph_lo == 0 && a.ph_hi == NPH_) (void)xcd_barrier_post((unsigned*)(a.ws + WS_CTL) + 4096, xst);
    int tid = threadIdx.x, bid = blockIdx.x;
    unsigned char* ws = a.ws;
#define ssq ((float*)(ws + WS_SSQ))
#define H ((float*)(ws + WS_H))
#define HB ((bf16_t*)(ws + WS_HB))
#define ACT ((bf16_t*)(ws + WS_ACT))
#define WB ((bf16_t*)(ws + WS_W))
#define tabP ((const float2*)(ws + WS_TABP))
#define tabM ((const float2*)(ws + WS_TABM))
#define QA ((bf16_t*)(ws + WS_QA))
#define KA ((bf16_t*)(ws + WS_KA))
#define VA ((bf16_t*)(ws + WS_VA))
#define QM ((bf16_t*)(ws + WS_QM))
#define CQ ((bf16_t*)(ws + WS_CQ))
#define CKV ((bf16_t*)(ws + WS_CKV))
#define KM ((bf16_t*)(ws + WS_KM))
#define OAB ((bf16_t*)((unsigned char*)a.out + OUT_OAB))
#define VM ((bf16_t*)((unsigned char*)a.out + OUT_VM))
#define QS ((bf16_t*)(ws + WS_QS))
#define KS ((bf16_t*)(ws + WS_KS))
#define VS ((bf16_t*)(ws + WS_VS))
#define OS ((bf16_t*)(ws + WS_OS))
    const int lo = a.ph_lo, hi = a.ph_hi;
#define IN(k) (lo <= (k) && (k) < hi)
#define REPS(k)
#define SEAM(k) do { if (IN(k) && IN((k) + 1)) { if (!(lo == 0 && hi == NPH_)) grid.sync(); else { XcdBarrier xb_; xb_.bar = (unsigned*)(a.ws + WS_CTL) + 4096; xb_.x = xb_xcc_id(); xb_.st = xst; xcd_barrier(xb_); } } } while (0)
#define RUN_GEMM(EpiT, E, Aptr, Bptr, N_, K_) do { int k_rt = (K_); asm volatile("" : "+s"(k_rt)); pg8::Gemm g{(Aptr), (Bptr), R, (N_), k_rt}; pg8::StaticOrder S; S.init(R, (N_), (int)gridDim.x, bid); \
        pg8::gemm_phase<EpiT, pg8::StaticOrder, true, true>(lds, g, S, (E)); } while (0)

#define LAUNDER_TID() do { tid = threadIdx.x; asm volatile("" : "+v"(tid)); { size_t z_ = 0; asm volatile("" : "+s"(z_)); ws = a.ws + z_; } bid = blockIdx.x; asm volatile("" : "+s"(bid)); } while (0)
#define RUN_RESID(E_, Aptr, Bptr, K_) do { int k_rt = (K_); asm volatile("" : "+s"(k_rt)); \
        pg8::StaticOrder S0; S0.init(R, D, (int)gridDim.x, bid); const int G_ = (int)gridDim.x, cap_ = (S0.nwg / G_) * G_, nleft_ = S0.nwg - cap_; \
        { pg8::Gemm g{(Aptr), (Bptr), R, D, k_rt, 0}; pg8::CapOrder S; S.init(R, D, G_, bid, cap_); pg8::gemm_phase<EpiResid, pg8::CapOrder, true, true>(lds, g, S, (E_)); } \
        { const int NS_ = k_rt >> 8; \
          for (int j_ = bid; j_ < nleft_ * NS_; j_ += G_) { const int e_ = j_ / NS_, sl_ = j_ % NS_; pg8::OneUnit S1; pg8::CapOrder::unit_of(S0, cap_ + e_, S1.u); \
              int nt_rt = 4; asm volatile("" : "+s"(nt_rt)); pg8::Gemm g{(Aptr) + sl_ * 256, (Bptr) + sl_ * 256, R, D, k_rt, nt_rt}; EpiPartial EA{(unsigned char*)a.out, e_, sl_}; pg8::gemm_phase<EpiPartial, pg8::OneUnit, true, true>(lds, g, S1, EA); } } } while (0)
#define RUN_FIXUP(ssq_idx_, has_bias_, alpha_, NS_) do { pg8::StaticOrder S0; S0.init(R, D, (int)gridDim.x, bid); const int G_ = (int)gridDim.x, cap_ = (S0.nwg / G_) * G_, nleft_ = S0.nwg - cap_; \
        const int lane_ = tid & 63; float* ssqo_ = ssq + (size_t)(ssq_idx_) * R; \
        for (int idx_ = bid * 8 + (tid >> 6); idx_ < nleft_ * 256; idx_ += G_ * 8) { const int e_ = idx_ >> 8, rl_ = idx_ & 255; pg8::Unit u_; pg8::CapOrder::unit_of(S0, cap_ + e_, u_); \
            const int row_ = u_.pm * 256 + rl_, c_ = u_.pn * 256 + lane_ * 4; const float* sp_ = (const float*)((unsigned char*)a.out + OUT_SPLIT) + (size_t)e_ * 11 * 65536 + rl_ * 256 + lane_ * 4; \
            f32x4 acc_ = *(const f32x4*)sp_; \
            _Pragma("unroll") for (int s_ = 1; s_ < (NS_); ++s_) acc_ += *(const f32x4*)(sp_ + (size_t)s_ * 65536); \
            f32x4 h4_ = *(const f32x4*)(H + (size_t)row_ * D + c_) + acc_ * (alpha_); \
            if (has_bias_) h4_ += *(const GAS f32x4*)(INP(22) + c_); \
            *(f32x4*)(H + (size_t)row_ * D + c_) = h4_; u32x2 w_; w_.x = pk_bf16(h4_[0], h4_[1]); w_.y = pk_bf16(h4_[2], h4_[3]); *(u32x2*)(HB + (size_t)row_ * D + c_) = w_; \
            const float ss_ = wave_sum((h4_[0] * h4_[0] + h4_[1] * h4_[1]) + (h4_[2] * h4_[2] + h4_[3] * h4_[3])); if (lane_ == 0) atomicAdd(ssqo_ + row_, ss_); } } while (0)
    if (IN(0)) { LAUNDER_TID(); REPS(0) { prologue(a, lds, tid); __syncthreads(); } }
    SEAM(0);
    int ph = 1;
    for (int l = 0; l < 2; ++l) {
        const bf16_t* Wgu1 = WB + WOFF_FFN + (size_t)(2 * l) * (W_GU + W_DN);
        if (IN(ph)) { LAUNDER_TID(); EpiSwiglu E{ws, 3 * l}; REPS(ph) RUN_GEMM(EpiSwiglu, E, HB, Wgu1, 5632, D); }
        SEAM(ph); ++ph;
        if (IN(ph)) { LAUNDER_TID(); EpiResid E{ws, 3 * l + 1, 0, 0.5f}; RUN_RESID(E, ACT, Wgu1 + W_GU, FF);
            if (l == 0) convert_weights(ws, lds, tid, W_ITEMS_L0, W_ITEMS, bid * 8 + (tid >> 6), (int)gridDim.x * 8); }
        SEAM(ph); ++ph;
        if (IN(ph)) { LAUNDER_TID(); RUN_FIXUP(3 * l + 1, 0, 0.5f, 11); }
        SEAM(ph); ++ph;
        if (l == 0) {
            if (IN(ph)) { LAUNDER_TID(); EpiWin E{ws, 0.125f * LOG2E}; RUN_GEMM(EpiWin, E, HB, WB + WOFF_WIN, NWIN, D); }
            SEAM(ph); ++ph;
            if (IN(ph)) { LAUNDER_TID();
                REPS(ph) { EpiUq E{ws, 0.07216878364870322f * LOG2E}; RUN_GEMM(EpiUq, E, CQ, WB + WOFF_UQ, NUQ, 256); }
                REPS(ph) { EpiUkv E{ws, (unsigned char*)a.out}; RUN_GEMM(EpiUkv, E, CKV, WB + WOFF_UKV, NUKV, 256); }
            }
            SEAM(ph); ++ph;
            if (IN(ph)) { LAUNDER_TID();
                LAUNDER_TID();
                if (tid < 64) {
                    const float s1 = wave_sum(INP(8)[tid] * INP(9)[tid]), s2 = wave_sum(INP(10)[tid] * INP(11)[tid]);
                    if (tid == 0) misc[1] = __float_as_uint(__expf(s1) - __expf(s2) + 0.2f);
                }
                __syncthreads();
                AttnL0 A{QA, KA, VA, QM, KM, VM, OAB, INP(12), __uint_as_float(misc[1])};
                unsigned* qctr = (unsigned*)(ws + WS_CTL);
                REPS(ph) {
                for (;;) {
                    if (tid == 0) misc[0] = atomicAdd(qctr, 1u);
                    __syncthreads();
                    const unsigned idx = misc[0];
                    __syncthreads();
                    if (idx >= 33u * 16u) break;
                    const int t = 32 - (int)(idx >> 4), rem = idx & 15;
                    attn_unit_diff(lds, A, rem & 3, rem >> 2, t, tid);
                }
                asm volatile("" ::: "memory");
                for (;;) {
                    if (tid == 0) misc[0] = atomicAdd(qctr + 64, 1u);
                    __syncthreads();
                    const unsigned idx = misc[0];
                    __syncthreads();
                    if (idx >= 33u * 16u) break;
                    const int t = 32 - (int)(idx >> 4), rem = idx & 15;
                    attn_unit_mla(lds, A, rem & 3, rem >> 2, t, tid);
                }
                }
            }
            SEAM(ph); ++ph;
            if (IN(ph)) { LAUNDER_TID(); EpiResid E{ws, 2, 0, 1.0f}; RUN_RESID(E, OAB, WB + WOFF_WO0, D); }
            SEAM(ph); ++ph;
            if (IN(ph)) { LAUNDER_TID(); RUN_FIXUP(2, 0, 1.0f, 4); }
            SEAM(ph); ++ph;
        } else {
            if (IN(ph)) { LAUNDER_TID(); EpiQkvS E{ws, 0.125f * LOG2E}; RUN_GEMM(EpiQkvS, E, HB, WB + WOFF_QKV, NQKV, D); }
            SEAM(ph); ++ph;
            if (IN(ph)) { LAUNDER_TID();
                LAUNDER_TID();
                AttnL1 A{QS, KS, VS, OS, INP(20)};
                REPS(ph) for (int u = bid; u < NB * 2 * 65; u += gridDim.x) { const int b = u / 130, rem = u % 130; attn_unit_swa(lds, A, b, rem / 65, rem % 65, tid); }
            }
            SEAM(ph); ++ph;
            if (IN(ph)) { LAUNDER_TID(); EpiResid E{ws, 5, 1, 1.0f}; RUN_RESID(E, OS, WB + WOFF_WO1, D); }
            SEAM(ph); ++ph;
            if (IN(ph)) { LAUNDER_TID(); RUN_FIXUP(5, 1, 1.0f, 4); }
            SEAM(ph); ++ph;
        }
        const bf16_t* Wgu2 = WB + WOFF_FFN + (size_t)(2 * l + 1) * (W_GU + W_DN);
        if (IN(ph)) { LAUNDER_TID(); EpiSwiglu E{ws, 3 * l + 2}; REPS(ph) RUN_GEMM(EpiSwiglu, E, HB, Wgu2, 5632, D); }
        SEAM(ph); ++ph;
        if (IN(ph)) { LAUNDER_TID(); EpiResid E{ws, 3 * l + 3, 0, 0.5f}; RUN_RESID(E, ACT, Wgu2 + W_GU, FF); }
        SEAM(ph); ++ph;
        if (IN(ph)) { LAUNDER_TID(); RUN_FIXUP(3 * l + 3, 0, 0.5f, 11); }
        SEAM(ph); ++ph;
    }
    if (IN(ph)) { LAUNDER_TID();
        LAUNDER_TID();
        const int lane = tid & 63, gw = bid * 8 + (tid >> 6), NGW = gridDim.x * 8;
        gcf gf = INP(27);
        REPS(ph) for (int s = gw; s < NB * SEQ; s += NGW) {
            const int row = (s / SEQ) * LROW + 128 + (s % SEQ);
            const float rstd = rsqrtf(ssq[(size_t)6 * R + row] * (1.0f / D) + EPS);
#pragma unroll
            for (int j = 0; j < 4; ++j) {
                const f32x4 v = *(const f32x4*)(H + (size_t)row * D + 256 * j + 4 * lane), gg = *(const GAS f32x4*)(gf + 256 * j + 4 * lane);
                *(f32x4*)(a.out + (size_t)s * D + 256 * j + 4 * lane) = v * rstd * gg;
            }
        }
    }
}
constexpr int NPH = 23;

extern "C" void kernel_launch(void* const* d_in, const int* in_sizes, int n_in, void* d_out, int out_size, void* d_ws, size_t ws_size, hipStream_t stream) {
    static int grid = 0;
    if (grid == 0) {
        if (n_in != 28 || out_size != NB * SEQ * D || ws_size < WS_END) { fprintf(stderr, "kernel_launch: unexpected problem (n_in %d out %d ws %zu)\n", n_in, out_size, ws_size); grid = -1; return; }
        int dev = 0, cus = 0, per = 0;
        (void)hipGetDevice(&dev); (void)hipDeviceGetAttribute(&cus, hipDeviceAttributeMultiprocessorCount, dev);
        (void)hipFuncSetAttribute((const void*)fwd, hipFuncAttributeMaxDynamicSharedMemorySize, LDS_BYTES);
        (void)hipOccupancyMaxActiveBlocksPerMultiprocessor(&per, (const void*)fwd, 512, LDS_BYTES);
        (void)hipGetLastError();
        grid = cus > 0 ? cus : 256;
    }
    if (grid < 0) return;
    Args a{};
    for (int i = 0; i < 28; ++i) a.in[i] = (const float*)d_in[i];
    a.out = (float*)d_out; a.ws = (unsigned char*)d_ws;
#if MK_PER_PHASE
    for (int p = 0; p < NPH; ++p) {
        const int reps = ((PROBE_MASK >> p) & 1u) ? PROBE_N : 1;
        for (int r = 0; r < reps; ++r) {
            if (p == 6 && r > 0) (void)hipMemsetAsync(d_ws, 0, 1024, stream);
            a.ph_lo = p; a.ph_hi = p + 1; hipLaunchKernelGGL(fwd, dim3(grid), dim3(512), LDS_BYTES, stream, a);
        }
    }
#else
    a.ph_lo = 0; a.ph_hi = NPH;
    (void)hipMemsetAsync((char*)d_ws + WS_CTL + 4096 * 4, 0, XCD_BAR_WORDS * 4, stream);
    void* args[] = {&a};
    hipError_t e = hipLaunchCooperativeKernel((const void*)fwd, dim3(grid), dim3(512), args, LDS_BYTES, stream);
    if (e != hipSuccess) fprintf(stderr, "cooperative launch failed: %s (grid %d)\n", hipGetErrorString(e), grid);
#endif
}
```

```cpp
#include <hip/hip_runtime.h>
#include <hip/hip_cooperative_groups.h>
#include <cstdio>
#include <cstdint>
#include <cmath>
namespace cg = cooperative_groups;
#ifndef MK_PER_PHASE
#define MK_PER_PHASE 0
#endif
#ifndef PROBE_MASK
#define PROBE_MASK 0u
#endif
#ifndef PROBE_N
#define PROBE_N 2
#endif
namespace pg8 {
#define PG8_LAS __attribute__((address_space(3)))
typedef unsigned short bf16_t;
typedef short bf16x8 __attribute__((ext_vector_type(8)));
typedef float f32x4 __attribute__((ext_vector_type(4)));
typedef unsigned u32x4 __attribute__((ext_vector_type(4)));
constexpr int BM = 256, BK = 64, HALF = 128, HTB = HALF * BK * 2  , STAGE_BYTES = 8 * HTB, NXCD = 8, WGM = 8;

__host__ __device__ __forceinline__ int lds_byte(int r, int c) { const int st = (r >> 4) * 2 + (c >> 5), rr = r & 15, cc = c & 31, ob = rr * 64 + cc * 2; return st * 1024 + (ob ^ (((ob >> 9) & 1) << 5)); }
__host__ __device__ __forceinline__ void stage_rc(int b, int& R, int& C) { const int st = b / 1024, sb = b % 1024, swz = sb ^ (((sb >> 9) & 1) << 5); R = (st >> 1) * 16 + swz / 64; C = (st & 1) * 32 + (swz % 64) / 2; }
__host__ __device__ __forceinline__ int perm32(int rho) { const int n = rho >> 4, i = rho & 15; return 8 * (i >> 2) + 4 * n + (i & 3); }

struct Unit { int pm, pn; };
struct Gemm { const bf16_t* A; const bf16_t* Bt; int M, N, K, nt; };

struct StaticOrder {
    int nM, nN, nwg, G, c;
    __host__ __device__ void init(int M, int N, int G_, int c_) { nM = M / BM; nN = N / BM; nwg = nM * nN; G = G_; c = c_; }
    __host__ __device__ bool next(int i, Unit& u) const {
        const long L = (long)i * G + c; if (L >= nwg) return false;
        int wgid = (int)L; { const int q = nwg / NXCD, r = nwg % NXCD, xcd = wgid % NXCD, off = wgid / NXCD; wgid = (xcd < r ? xcd * (q + 1) : r * (q + 1) + (xcd - r) * q) + off; }
        const int nig = WGM * nN, gid = wgid / nig, fm = gid * WGM, gsz = (nM - fm) < WGM ? (nM - fm) : WGM;
        u.pm = fm + ((wgid % nig) % gsz); u.pn = (wgid % nig) / gsz; return true;
    }
    __device__ __forceinline__ void a_ready(const Unit&) const {}
    __device__ __forceinline__ void done(const Unit&) const {}
};
struct CapOrder {
    StaticOrder b; int cap;
    __host__ __device__ void init(int M, int N, int G_, int c_, int cap_) { b.init(M, N, G_, c_); cap = cap_; }
    __host__ __device__ __forceinline__ static void unit_of(const StaticOrder& o, int L, Unit& u) {
        int wgid = L; { const int q = o.nwg / NXCD, r = o.nwg % NXCD, xcd = wgid % NXCD, off = wgid / NXCD; wgid = (xcd < r ? xcd * (q + 1) : r * (q + 1) + (xcd - r) * q) + off; }
        const int nig = WGM * o.nN, gid = wgid / nig, fm = gid * WGM, gsz = (o.nM - fm) < WGM ? (o.nM - fm) : WGM;
        u.pm = fm + ((wgid % nig) % gsz); u.pn = (wgid % nig) / gsz;
    }
    __host__ __device__ __forceinline__ bool next(int i, Unit& u) const { const long L = (long)i * b.G + b.c; if (L >= cap) return false; unit_of(b, (int)L, u); return true; }
    __device__ __forceinline__ void a_ready(const Unit&) const {}
    __device__ __forceinline__ void done(const Unit&) const {}
};
struct OneUnit {
    Unit u;
    __host__ __device__ __forceinline__ bool next(int i, Unit& o) const { if (i != 0) return false; o = u; return true; }
    __device__ __forceinline__ void a_ready(const Unit&) const {}
    __device__ __forceinline__ void done(const Unit&) const {}
};


__device__ __forceinline__ unsigned cvt_pk_bf16(float lo, float hi) { unsigned r; asm volatile("v_cvt_pk_bf16_f32 %0, %1, %2" : "=v"(r) : "v"(lo), "v"(hi)); return r; }
template <class Epi, class Sched, bool ALIGN_EPI = false, bool SP2 = false>
__device__ __forceinline__ void gemm_phase(PG8_LAS unsigned char* lds, const Gemm g, const Sched& S, const Epi& E) {
    int tid_l = threadIdx.x; asm volatile("" : "+v"(tid_l)); const int tid = tid_l, wid = __builtin_amdgcn_readfirstlane(tid >> 6), lane = tid & 63, wr = wid >> 2, wc = wid & 3, fr = lane & 15, fq = lane >> 4;
    const int K = g.K, nt = g.nt > 0 ? g.nt : K / BK;
    unsigned voffA[2], voffB[2];
#pragma unroll
    for (int i = 0; i < 2; ++i) { int R, C; stage_rc(tid * 16 + i * 8192, R, C); const int Rb = Epi::PERM ? ((R & ~31) + perm32(R & 31)) : R;
        voffA[i] = (unsigned)(R * K + C) * 2u; voffB[i] = (unsigned)(Rb * K + C) * 2u; }
    const size_t kstep = (size_t)(BK * 2);
    const size_t hstep = (size_t)HALF * K * 2;
    const size_t tstep = 2 * hstep;
    const unsigned ldsw = (unsigned)wid * 1024u;
    const int aoff = lds_byte(wr * 64 + fr, fq * 8), boff = lds_byte(wc * 32 + fr, fq * 8);
#define PG8_SA(b, h) (((b) * 2 + (h)) * HTB)
#define PG8_SB(b, h) ((4 + (b) * 2 + (h)) * HTB)
#define PG8_STAGE(bufoff, gbase, voff) do { _Pragma("unroll") for (int _i = 0; _i < 2; ++_i) \
        __builtin_amdgcn_global_load_lds((const unsigned*)((const char*)(gbase) + (voff)[_i]), (PG8_LAS unsigned*)(lds + (bufoff) + ldsw + _i * 8192), 16, 0, 0); } while (0)
#define PG8_LDA(dst, b, h) do { _Pragma("unroll") for (int m = 0; m < 4; ++m) _Pragma("unroll") for (int k = 0; k < 2; ++k) dst[m][k] = *(const PG8_LAS bf16x8*)(lds + PG8_SA(b, h) + aoff + m * 2048 + k * 1024); } while (0)
#define PG8_LDB(dst, b, h) do { _Pragma("unroll") for (int n = 0; n < 2; ++n) _Pragma("unroll") for (int k = 0; k < 2; ++k) dst[n][k] = *(const PG8_LAS bf16x8*)(lds + PG8_SB(b, h) + boff + n * 2048 + k * 1024); } while (0)
#define PG8_MMA(ai, bj, At, Bt) do { __builtin_amdgcn_s_setprio(1); _Pragma("unroll") for (int m = 0; m < 4; ++m) _Pragma("unroll") for (int n = 0; n < 2; ++n) _Pragma("unroll") for (int k = 0; k < 2; ++k) \
        acc[ai][bj][m][n] = __builtin_amdgcn_mfma_f32_16x16x32_bf16(Bt[n][k], At[m][k], acc[ai][bj][m][n], 0, 0, 0); __builtin_amdgcn_s_setprio(0); } while (0)
#define PG8_WAIT_V(n) asm volatile("s_waitcnt vmcnt(" #n ")" ::: "memory")
#define PG8_WAIT_L(n) asm volatile("s_waitcnt lgkmcnt(" #n ")" ::: "memory")
#define PG8_BAR __builtin_amdgcn_s_barrier()
#define PG8_SCHED __builtin_amdgcn_sched_barrier(0)
    Unit cur, nxt; int ui = 0;
    if (!S.next(0, cur)) return;
    f32x4 acc[2][2][4][2];
#pragma unroll
    for (int a = 0; a < 2; ++a)
#pragma unroll
        for (int b = 0; b < 2; ++b)
#pragma unroll
            for (int m = 0; m < 4; ++m)
#pragma unroll
                for (int n = 0; n < 2; ++n) acc[a][b][m][n] = (f32x4){0.f, 0.f, 0.f, 0.f};
    bf16x8 At[4][2], B0[2][2], B1[2][2];
    const char* cA = (const char*)g.A + (size_t)cur.pm * tstep; const char* cB = (const char*)g.Bt + (size_t)cur.pn * tstep;
    S.a_ready(cur);
    if constexpr (SP2) {
        PG8_STAGE(PG8_SB(0, 0), cB, voffB); PG8_STAGE(PG8_SB(0, 1), cB + hstep, voffB); PG8_STAGE(PG8_SA(0, 0), cA, voffA); PG8_STAGE(PG8_SA(0, 1), cA + hstep, voffA);
        if (wr == 1) PG8_BAR;
        PG8_WAIT_V(2); PG8_BAR;
        PG8_STAGE(PG8_SB(1, 0), cB + kstep, voffB); PG8_STAGE(PG8_SA(1, 0), cA + kstep, voffA); PG8_STAGE(PG8_SB(1, 1), cB + hstep + kstep, voffB);
        PG8_WAIT_V(6); PG8_BAR;
    } else {
        PG8_STAGE(PG8_SB(0, 0), cB, voffB); PG8_STAGE(PG8_SA(0, 0), cA, voffA); PG8_STAGE(PG8_SB(0, 1), cB + hstep, voffB); PG8_STAGE(PG8_SA(0, 1), cA + hstep, voffA);
        if (wr == 1) PG8_BAR;
        PG8_WAIT_V(4); PG8_BAR;
        PG8_STAGE(PG8_SB(1, 0), cB + kstep, voffB); PG8_STAGE(PG8_SA(1, 0), cA + kstep, voffA); PG8_STAGE(PG8_SB(1, 1), cB + hstep + kstep, voffB);
        PG8_WAIT_V(6); PG8_BAR;
    }
    for (;;) {
        const bool has_next = S.next(ui + 1, nxt);
        const char* nA = has_next ? (const char*)g.A + (size_t)nxt.pm * tstep : cA; const char* nB = has_next ? (const char*)g.Bt + (size_t)nxt.pn * tstep : cB;
        for (int t = 0; t < nt; t += 2) {
            const bool last = (t == nt - 2);
            const char* a1 = cA + (size_t)(t + 1) * kstep;
            const char* a2 = last ? nA : cA + (size_t)(t + 2) * kstep; const char* b2 = last ? nB : cB + (size_t)(t + 2) * kstep;
            const char* a3 = a2 + kstep; const char* b3 = b2 + kstep;
            if (last && has_next) S.a_ready(nxt);
            if constexpr (SP2) {
            PG8_LDB(B0, 0, 0); PG8_LDB(B1, 0, 1); PG8_SCHED; PG8_LDA(At, 0, 0); PG8_STAGE(PG8_SA(1, 1), a1 + hstep, voffA);
            PG8_WAIT_V(8); PG8_WAIT_L(0); PG8_BAR; PG8_MMA(0, 0, At, B0); PG8_MMA(0, 1, At, B1); PG8_BAR; PG8_SCHED;
            PG8_LDA(At, 0, 1); PG8_STAGE(PG8_SB(0, 0), b2, voffB); PG8_STAGE(PG8_SB(0, 1), b2 + hstep, voffB); PG8_STAGE(PG8_SA(0, 0), a2, voffA);
            PG8_WAIT_V(8); PG8_WAIT_L(0); PG8_BAR; PG8_MMA(1, 0, At, B0); PG8_MMA(1, 1, At, B1); PG8_BAR; PG8_SCHED;
            PG8_LDB(B0, 1, 0); PG8_LDB(B1, 1, 1); PG8_SCHED; PG8_LDA(At, 1, 0); PG8_STAGE(PG8_SA(0, 1), a2 + hstep, voffA);
            PG8_WAIT_V(8); PG8_WAIT_L(0); PG8_BAR; PG8_MMA(0, 0, At, B0); PG8_MMA(0, 1, At, B1); PG8_BAR; PG8_SCHED;
            PG8_LDA(At, 1, 1); PG8_STAGE(PG8_SB(1, 0), b3, voffB); PG8_STAGE(PG8_SB(1, 1), b3 + hstep, voffB); PG8_STAGE(PG8_SA(1, 0), a3, voffA);
            PG8_WAIT_V(8); PG8_WAIT_L(0); PG8_BAR; PG8_MMA(1, 0, At, B0); PG8_MMA(1, 1, At, B1); PG8_BAR; PG8_SCHED;
            } else {
            PG8_LDB(B0, 0, 0); PG8_SCHED; PG8_LDA(At, 0, 0); PG8_STAGE(PG8_SA(1, 1), a1 + hstep, voffA);
            PG8_WAIT_L(8); PG8_BAR; PG8_WAIT_L(0); PG8_MMA(0, 0, At, B0); PG8_BAR; PG8_SCHED;
            PG8_LDB(B1, 0, 1); PG8_STAGE(PG8_SB(0, 0), b2, voffB);
            PG8_BAR; PG8_WAIT_L(0); PG8_MMA(0, 1, At, B1); PG8_BAR;
            PG8_LDA(At, 0, 1); PG8_STAGE(PG8_SA(0, 0), a2, voffA);
            PG8_BAR; PG8_WAIT_L(0); PG8_MMA(1, 0, At, B0); PG8_BAR; PG8_SCHED;
            PG8_STAGE(PG8_SB(0, 1), b2 + hstep, voffB);
            PG8_WAIT_V(6); PG8_BAR; PG8_MMA(1, 1, At, B1); PG8_BAR;
            PG8_LDB(B0, 1, 0); PG8_SCHED; PG8_LDA(At, 1, 0); PG8_STAGE(PG8_SA(0, 1), a2 + hstep, voffA);
            PG8_WAIT_L(8); PG8_BAR; PG8_WAIT_L(0); PG8_MMA(0, 0, At, B0); PG8_BAR; PG8_SCHED;
            PG8_LDB(B1, 1, 1); PG8_STAGE(PG8_SB(1, 0), b3, voffB);
            PG8_BAR; PG8_WAIT_L(0); PG8_MMA(0, 1, At, B1); PG8_BAR;
            PG8_LDA(At, 1, 1); PG8_STAGE(PG8_SA(1, 0), a3, voffA);
            PG8_BAR; PG8_WAIT_L(0); PG8_MMA(1, 0, At, B0); PG8_BAR; PG8_SCHED;
            PG8_STAGE(PG8_SB(1, 1), b3 + hstep, voffB);
            PG8_WAIT_V(6); PG8_BAR; PG8_MMA(1, 1, At, B1); PG8_BAR;
            }
        }
        if constexpr (ALIGN_EPI) { if (wr == 0) PG8_BAR; }
        if constexpr (!Epi::AFTER_DRAIN) { E(acc, cur, wr, wc, fr, fq); S.done(cur); }
        if (!has_next) break;
#pragma unroll
        for (int a = 0; a < 2; ++a)
#pragma unroll
            for (int b = 0; b < 2; ++b)
#pragma unroll
                for (int m = 0; m < 4; ++m)
#pragma unroll
                    for (int n = 0; n < 2; ++n) acc[a][b][m][n] = (f32x4){0.f, 0.f, 0.f, 0.f};
        cur = nxt; cA = nA; cB = nB; ++ui;
        if constexpr (ALIGN_EPI) { if (wr == 1) PG8_BAR; }
    }
    PG8_WAIT_V(0);
    if constexpr (!ALIGN_EPI) { if (wr == 0) PG8_BAR; }
    PG8_BAR;
    if constexpr (Epi::AFTER_DRAIN) { E.fused(acc, cur, wr, wc, fr, fq, lds, wid, lane); S.done(cur); }
#undef PG8_SA
#undef PG8_SB
#undef PG8_STAGE
#undef PG8_LDA
#undef PG8_LDB
#undef PG8_MMA
#undef PG8_WAIT_V
#undef PG8_WAIT_L
#undef PG8_BAR
#undef PG8_SCHED
}
}
#define LAS __attribute__((address_space(3)))
#define DI __device__ __forceinline__
typedef unsigned short bf16_t;
typedef short bf16x8 __attribute__((ext_vector_type(8)));
typedef short s16x4 __attribute__((ext_vector_type(4)));
typedef float f32x4 __attribute__((ext_vector_type(4)));
typedef float f32x16 __attribute__((ext_vector_type(16)));
typedef unsigned u32x4 __attribute__((ext_vector_type(4)));
typedef unsigned u32x2 __attribute__((ext_vector_type(2)));
typedef float f32x2_t __attribute__((ext_vector_type(2)));
typedef __bf16 bf16x2_t __attribute__((ext_vector_type(2)));

constexpr int NB = 4, SEQ = 8192, LROW = 8320, R = NB * LROW, D = 1024, FF = 2816, NFRONT = 112, NPOS = 8208;
constexpr int NWIN = 2304, NUQ = 768, NUKV = 1024, NQKV = 1280;
constexpr float LOG2E = 1.4426950408889634f;
constexpr float NEGBIG = -1e30f;
constexpr float EPS = 1e-6f;

constexpr size_t MiB = 1u << 20;
constexpr size_t WS_CTL = 0;
constexpr size_t WS_SSQ = 1 * MiB;
constexpr size_t WS_TABP = 3 * MiB;
constexpr size_t WS_TABM = WS_TABP + 768 * 1024;
constexpr size_t WS_W = 6 * MiB;
constexpr size_t W_GU = (size_t)5632 * 1024, W_DN = (size_t)1024 * 2816;
constexpr size_t WOFF_FFN = 0;
constexpr size_t WOFF_WIN = 4 * (W_GU + W_DN);
constexpr size_t WOFF_UQ = WOFF_WIN + (size_t)NWIN * 1024;
constexpr size_t WOFF_UKV = WOFF_UQ + (size_t)NUQ * 256;
constexpr size_t WOFF_WO0 = WOFF_UKV + (size_t)NUKV * 256;
constexpr size_t WOFF_QKV = WOFF_WO0 + (size_t)1024 * 1024;
constexpr size_t WOFF_WO1 = WOFF_QKV + (size_t)NQKV * 1024;
constexpr size_t W_TOTAL = WOFF_WO1 + (size_t)1024 * 1024;
constexpr size_t WS_BQKV = WS_W + 80 * MiB;
static_assert(W_TOTAL * 2 <= 79 * MiB, "weights fit");
constexpr size_t WS_H = 87 * MiB;
constexpr size_t WS_HB = WS_H + (size_t)R * D * 4;
constexpr size_t WS_ACT = WS_HB + (size_t)R * D * 2;
constexpr size_t SZ512 = (size_t)R * 512 * 2, SZ768 = (size_t)R * 768 * 2, SZ256 = (size_t)R * 256 * 2;
constexpr size_t WS_QA = WS_ACT, WS_KA = WS_QA + SZ512, WS_VA = WS_KA + SZ512, WS_QM = WS_VA + SZ512, WS_CQ = WS_QM + SZ768, WS_CKV = WS_CQ + SZ256;
static_assert(WS_CKV + SZ256 <= WS_ACT + (size_t)R * FF * 2, "layer-0 attention inputs overlay act");
constexpr size_t WS_KM = WS_ACT + (size_t)R * FF * 2;
constexpr size_t WS_END = WS_KM + SZ768;
static_assert(WS_END <= 512 * MiB, "d_ws map fits 512 MiB");
constexpr size_t WS_QS = WS_ACT, WS_KS = WS_QS + (size_t)R * 1024 * 2, WS_VS = WS_KS + (size_t)R * 128 * 2, WS_OS = WS_VS + (size_t)R * 128 * 2;
static_assert(WS_OS + (size_t)R * 1024 * 2 <= WS_KM, "layer-1 attention buffers overlay act");
constexpr size_t OUT_OAB = 0, OUT_VM = (size_t)R * 1024 * 2;
constexpr size_t OUT_SPLIT = 98 * MiB;
static_assert(OUT_VM + SZ512 <= OUT_SPLIT && OUT_SPLIT + (size_t)8 * 11 * 65536 * 4 <= (size_t)NB * SEQ * D * 4, "d_out scratch");

constexpr int LDS_BYTES = 147456, LDS_MISC = 131072;

struct Args {
    const float* in[28]; float* out; unsigned char* ws; int ph_lo, ph_hi;
};

#define GAS __attribute__((address_space(1)))
typedef const GAS float* gcf;
DI gcf INP(int i) { asm volatile("" : "+s"(i)); return ((const gcf*)__builtin_amdgcn_kernarg_segment_ptr())[i]; }
DI unsigned pk_bf16(float lo, float hi) { f32x2_t v = {lo, hi}; bf16x2_t b = __builtin_convertvector(v, bf16x2_t); return __builtin_bit_cast(unsigned, b); }
DI float bf_lo(unsigned u) { return __uint_as_float(u << 16); }
DI float bf_hi(unsigned u) { return __uint_as_float(u & 0xffff0000u); }
DI int row_pos(int row) { const int i = row % LROW; return i > NFRONT ? i - NFRONT : 0; }
DI int permP(int d) { return d < 16 ? ((d & 1) ? (d >> 1) + 8 : (d >> 1)) : d; }
DI int permM(int d) { return (d & 1) ? (d >> 1) + 32 : (d >> 1); }
DI float wave_sum(float v) {
#pragma unroll
    for (int o = 1; o < 64; o <<= 1) v += __shfl_xor(v, o);
    return v;
}
DI void rope8(f32x4& v0, f32x4& v1, const float2* tab) {
    const float2 t0 = tab[0], t1 = tab[1], t2 = tab[2], t3 = tab[3];
    f32x4 a = v0, b = v1;
    v0[0] = a[0] * t0.x - a[1] * t0.y; v0[1] = a[1] * t0.x + a[0] * t0.y;
    v0[2] = a[2] * t1.x - a[3] * t1.y; v0[3] = a[3] * t1.x + a[2] * t1.y;
    v1[0] = b[0] * t2.x - b[1] * t2.y; v1[1] = b[1] * t2.x + b[0] * t2.y;
    v1[2] = b[2] * t3.x - b[3] * t3.y; v1[3] = b[3] * t3.x + b[2] * t3.y;
}
DI u32x4 pack8(const f32x4& a, const f32x4& b) { u32x4 w; w.x = pk_bf16(a[0], a[1]); w.y = pk_bf16(a[2], a[3]); w.z = pk_bf16(b[0], b[1]); w.w = pk_bf16(b[2], b[3]); return w; }

#define EPI_ROW(ai, m) (u.pm * 256 + (ai) * 128 + wr * 64 + (m) * 16 + fr)
typedef const f32x4 (&AccRef)[2][2][4][2];

struct EpiSwiglu {
    static constexpr bool PERM = true, AFTER_DRAIN = false;
    unsigned char* ws; int ssq_idx;
    DI void operator()(AccRef acc, const pg8::Unit& u, int wr, int wc, int fr, int fq) const {
        bf16_t* O = (bf16_t*)(ws + WS_ACT); const float* ssq = (const float*)(ws + WS_SSQ) + (size_t)ssq_idx * R;
        const int f0 = u.pn * 128 + wc * 32 + fq * 8;
#pragma unroll
        for (int ai = 0; ai < 2; ++ai)
#pragma unroll
            for (int m = 0; m < 4; ++m) {
                const int row = EPI_ROW(ai, m); asm volatile("" ::: "memory");
                const float rstd = rsqrtf(ssq[row] * (1.0f / D) + EPS);
                f32x4 o[2];
#pragma unroll
                for (int n = 0; n < 2; ++n) {
                    const f32x4 g = acc[ai][0][m][n] * rstd, up = acc[ai][1][m][n] * rstd;
#pragma unroll
                    for (int e = 0; e < 4; ++e) o[n][e] = g[e] * __builtin_amdgcn_rcpf(1.0f + __builtin_amdgcn_exp2f(-g[e] * LOG2E)) * up[e];
                }
                *(u32x4*)(O + (size_t)row * FF + f0) = pack8(o[0], o[1]);
            }
    }
};

struct EpiResid {
    static constexpr bool PERM = true, AFTER_DRAIN = false;
    unsigned char* ws; int ssq_idx; int has_bias; float alpha;
    DI void operator()(AccRef acc, const pg8::Unit& u, int wr, int wc, int fr, int fq) const {
        float* h = (float*)(ws + WS_H); bf16_t* hb = (bf16_t*)(ws + WS_HB); float* ssq_out = (float*)(ws + WS_SSQ) + (size_t)ssq_idx * R; gcf bias = has_bias ? INP(22) : nullptr;
#pragma unroll
        for (int ai = 0; ai < 2; ++ai)
#pragma unroll
            for (int m = 0; m < 4; ++m) {
                const int row = EPI_ROW(ai, m); if (m == 0) asm volatile("" ::: "memory");
                float ss = 0.f;
#pragma unroll
                for (int bj = 0; bj < 2; ++bj) {
                    const int c = u.pn * 256 + bj * 128 + wc * 32 + fq * 8;
                    float* hp = h + (size_t)row * D + c;
                    f32x4 h0 = __builtin_nontemporal_load((const f32x4*)hp), h1 = __builtin_nontemporal_load((const f32x4*)(hp + 4));
                    h0 += acc[ai][bj][m][0] * alpha; h1 += acc[ai][bj][m][1] * alpha;
                    if (bias) { h0 += *(const GAS f32x4*)(bias + c); h1 += *(const GAS f32x4*)(bias + c + 4); }
                    __builtin_nontemporal_store(h0, (f32x4*)hp); __builtin_nontemporal_store(h1, (f32x4*)(hp + 4));
                    *(u32x4*)(hb + (size_t)row * D + c) = pack8(h0, h1);
                    ss += (h0[0] * h0[0] + h0[1] * h0[1]) + (h0[2] * h0[2] + h0[3] * h0[3]) + (h1[0] * h1[0] + h1[1] * h1[1]) + (h1[2] * h1[2] + h1[3] * h1[3]);
                }
                ss += __shfl_xor(ss, 16); ss += __shfl_xor(ss, 32);
                if (fq == 0) atomicAdd(ssq_out + row, ss);
            }
    }
};

struct EpiPartial {
    static constexpr bool PERM = true, AFTER_DRAIN = false;
    unsigned char* outb; int e, sl;
    DI void operator()(AccRef acc, const pg8::Unit& u, int wr, int wc, int fr, int fq) const {
        float* sp = (float*)(outb + OUT_SPLIT) + ((size_t)e * 11 + sl) * 65536;
#pragma unroll
        for (int ai = 0; ai < 2; ++ai)
#pragma unroll
            for (int m = 0; m < 4; ++m) {
                const int rl = ai * 128 + wr * 64 + m * 16 + fr;
#pragma unroll
                for (int bj = 0; bj < 2; ++bj) {
                    float* p = sp + rl * 256 + bj * 128 + wc * 32 + fq * 8;
                    *(f32x4*)p = acc[ai][bj][m][0]; *(f32x4*)(p + 4) = acc[ai][bj][m][1];
                }
            }
    }
};

struct EpiWin {
    static constexpr bool PERM = true, AFTER_DRAIN = false;
    unsigned char* ws; float qscale;
    DI void operator()(AccRef acc, const pg8::Unit& u, int wr, int wc, int fr, int fq) const {
        const float* ssq = (const float*)(ws + WS_SSQ) + (size_t)1 * R; float* ssq_cq = (float*)(ws + WS_SSQ) + (size_t)7 * R; float* ssq_ckv = (float*)(ws + WS_SSQ) + (size_t)8 * R;
        bf16_t *QA = (bf16_t*)(ws + WS_QA), *KA = (bf16_t*)(ws + WS_KA), *VA = (bf16_t*)(ws + WS_VA), *CQ = (bf16_t*)(ws + WS_CQ), *CKV = (bf16_t*)(ws + WS_CKV), *KM = (bf16_t*)(ws + WS_KM);
        const float2* tabP = (const float2*)(ws + WS_TABP); const float2* tabM = (const float2*)(ws + WS_TABM);
        const int pn = u.pn;
#pragma unroll
        for (int ai = 0; ai < 2; ++ai)
#pragma unroll
            for (int m = 0; m < 4; ++m) {
                const int row = EPI_ROW(ai, m); asm volatile("" ::: "memory");
                const int pos = row_pos(row);
                const float rstd = rsqrtf(ssq[row] * (1.0f / D) + EPS);
                float ss = 0.f;
#pragma unroll
                for (int bj = 0; bj < 2; ++bj) {
                    const int cl = bj * 128 + wc * 32 + fq * 8;
                    f32x4 v0 = acc[ai][bj][m][0] * rstd, v1 = acc[ai][bj][m][1] * rstd;
                    if (pn < 4) {
                        if ((cl & 63) < 16) rope8(v0, v1, tabP + pos * 8 + ((cl & 63) >> 1));
                        if (pn < 2) { v0 *= qscale; v1 *= qscale; }
                        bf16_t* dst = (pn < 2 ? QA : KA) + (size_t)row * 512 + (pn & 1) * 256 + cl;
                        *(u32x4*)dst = pack8(v0, v1);
                    } else if (pn < 6) {
                        *(u32x4*)(VA + (size_t)row * 512 + (pn - 4) * 256 + cl) = pack8(v0, v1);
                    } else if (pn < 8) {
                        *(u32x4*)((pn == 6 ? CQ : CKV) + (size_t)row * 256 + cl) = pack8(v0, v1);
                        ss += (v0[0] * v0[0] + v0[1] * v0[1]) + (v0[2] * v0[2] + v0[3] * v0[3]) + (v1[0] * v1[0] + v1[1] * v1[1]) + (v1[2] * v1[2] + v1[3] * v1[3]);
                    } else if (cl < 64) {
                        rope8(v0, v1, tabM + pos * 32 + (cl >> 1));
                        const u32x4 w = pack8(v0, v1);
#pragma unroll
                        for (int hh = 0; hh < 4; ++hh) *(u32x4*)(KM + (size_t)row * 768 + hh * 192 + 128 + cl) = w;
                    }
                }
                if (pn == 6 || pn == 7) {
                    ss += __shfl_xor(ss, 16); ss += __shfl_xor(ss, 32);
                    if (fq == 0) atomicAdd((pn == 6 ? ssq_cq : ssq_ckv) + row, ss);
                }
            }
    }
};

struct EpiUq {
    static constexpr bool PERM = true, AFTER_DRAIN = false;
    unsigned char* ws; float qscale;
    DI void operator()(AccRef acc, const pg8::Unit& u, int wr, int wc, int fr, int fq) const {
        const float* ssq_cq = (const float*)(ws + WS_SSQ) + (size_t)7 * R; bf16_t* QM = (bf16_t*)(ws + WS_QM); const float2* tabM = (const float2*)(ws + WS_TABM);
#pragma unroll
        for (int ai = 0; ai < 2; ++ai)
#pragma unroll
            for (int m = 0; m < 4; ++m) {
                const int row = EPI_ROW(ai, m); asm volatile("" ::: "memory");
                const int pos = row_pos(row);
                const float rstd = rsqrtf(ssq_cq[row] * (1.0f / 256) + EPS);
#pragma unroll
                for (int bj = 0; bj < 2; ++bj) {
                    const int c = u.pn * 256 + bj * 128 + wc * 32 + fq * 8;
                    const int d = c % 192;
                    f32x4 v0 = acc[ai][bj][m][0] * rstd, v1 = acc[ai][bj][m][1] * rstd;
                    if (d >= 128) rope8(v0, v1, tabM + pos * 32 + ((d - 128) >> 1));
                    v0 *= qscale; v1 *= qscale;
                    *(u32x4*)(QM + (size_t)row * 768 + c) = pack8(v0, v1);
                }
            }
    }
};

struct EpiUkv {
    static constexpr bool PERM = true, AFTER_DRAIN = false;
    unsigned char* ws; unsigned char* outb;
    DI void operator()(AccRef acc, const pg8::Unit& u, int wr, int wc, int fr, int fq) const {
        const float* ssq_ckv = (const float*)(ws + WS_SSQ) + (size_t)8 * R; bf16_t* KM = (bf16_t*)(ws + WS_KM); bf16_t* VM = (bf16_t*)(outb + OUT_VM);
#pragma unroll
        for (int ai = 0; ai < 2; ++ai)
#pragma unroll
            for (int m = 0; m < 4; ++m) {
                const int row = EPI_ROW(ai, m); asm volatile("" ::: "memory");
                const float rstd = rsqrtf(ssq_ckv[row] * (1.0f / 256) + EPS);
                const int cl = wc * 32 + fq * 8;
                *(u32x4*)(KM + (size_t)row * 768 + u.pn * 192 + cl) = pack8(acc[ai][0][m][0] * rstd, acc[ai][0][m][1] * rstd);
                *(u32x4*)(VM + (size_t)row * 512 + u.pn * 128 + cl) = pack8(acc[ai][1][m][0] * rstd, acc[ai][1][m][1] * rstd);
            }
    }
};

struct EpiQkvS {
    static constexpr bool PERM = true, AFTER_DRAIN = false;
    unsigned char* ws; float qscale;
    DI void operator()(AccRef acc, const pg8::Unit& u, int wr, int wc, int fr, int fq) const {
        const float* ssq = (const float*)(ws + WS_SSQ) + (size_t)4 * R; const float* bias = (const float*)(ws + WS_BQKV); bf16_t *QS = (bf16_t*)(ws + WS_QS), *KS = (bf16_t*)(ws + WS_KS), *VS = (bf16_t*)(ws + WS_VS); const float2* tabP = (const float2*)(ws + WS_TABP);
        const int pn = u.pn;
#pragma unroll
        for (int ai = 0; ai < 2; ++ai)
#pragma unroll
            for (int m = 0; m < 4; ++m) {
                const int row = EPI_ROW(ai, m); asm volatile("" ::: "memory");
                const int pos = row_pos(row);
                const float rstd = rsqrtf(ssq[row] * (1.0f / D) + EPS);
#pragma unroll
                for (int bj = 0; bj < 2; ++bj) {
                    const int cl = bj * 128 + wc * 32 + fq * 8, c = pn * 256 + cl;
                    f32x4 v0 = acc[ai][bj][m][0] * rstd + *(const f32x4*)(bias + c), v1 = acc[ai][bj][m][1] * rstd + *(const f32x4*)(bias + c + 4);
                    const bool isv = (pn == 4 && bj == 1);
                    if (!isv && (cl & 63) < 16) rope8(v0, v1, tabP + pos * 8 + ((cl & 63) >> 1));
                    if (pn < 4) { v0 *= qscale; v1 *= qscale; *(u32x4*)(QS + (size_t)row * 1024 + c) = pack8(v0, v1); }
                    else if (bj == 0) *(u32x4*)(KS + (size_t)row * 128 + cl) = pack8(v0, v1);
                    else *(u32x4*)(VS + (size_t)row * 128 + (cl - 128)) = pack8(v0, v1);
                }
            }
    }
};
#define MFMA32(a, b, c) __builtin_amdgcn_mfma_f32_32x32x16_bf16((a), (b), (c), 0, 0, 0)
typedef short v4i16_t __attribute__((ext_vector_type(4)));
DI s16x4 tr_read(const LAS unsigned char* p) { return __builtin_bit_cast(s16x4, __builtin_amdgcn_ds_read_tr16_b64_v4i16((LAS v4i16_t*)p)); }
DI float xhalf_max(float v) { auto rr = __builtin_amdgcn_permlane32_swap(__float_as_uint(v), __float_as_uint(v), false, false); return fmaxf(__uint_as_float(rr[0]), __uint_as_float(rr[1])); }
DI float xhalf_sum(float v) { auto rr = __builtin_amdgcn_permlane32_swap(__float_as_uint(v), __float_as_uint(v), false, false); return __uint_as_float(rr[0]) + __uint_as_float(rr[1]); }
DI float max3f(float a, float b, float c) { float r; asm("v_max3_f32 %0, %1, %2, %3" : "=v"(r) : "v"(a), "v"(b), "v"(c)); return r; }
DI int crow(int i, int h) { return (i & 3) + 8 * (i >> 2) + 4 * h; }

template <int DQK, int DV, int KP, int VP, bool MASKED, class MaskF>
DI void attn_tile(const LAS unsigned char* Ks, const LAS unsigned char* Vs, const bf16x8 (&qf)[DQK / 16], f32x16 (&o)[DV / 32], float& m, float& l, int lane, const MaskF& allowed) {
    const int r = lane & 31, h = lane >> 5;
    f32x16 s0, s1;
#pragma unroll
    for (int i = 0; i < 16; ++i) { s0[i] = 0.f; s1[i] = 0.f; }
    const LAS unsigned char* kb = Ks + r * KP + h * 16;
    __builtin_amdgcn_s_setprio(1);
#pragma unroll
    for (int ks = 0; ks < DQK / 16; ++ks) {
        if ((ks & 3) == 0 && ks) asm volatile("" ::: "memory");
        const bf16x8 a0 = *(const LAS bf16x8*)(kb + ks * 32);
        const bf16x8 a1 = *(const LAS bf16x8*)(kb + 32 * KP + ks * 32);
        s0 = MFMA32(a0, qf[ks], s0); s1 = MFMA32(a1, qf[ks], s1);
    }
    __builtin_amdgcn_s_setprio(0);
    constexpr bool PFV = (DQK <= 64);
    const int q4 = (lane & 15) >> 2, p4 = lane & 3, blk = (lane >> 4) & 1;
    const LAS unsigned char* vb = Vs + (4 * h + q4) * VP + (16 * blk + 4 * p4) * 2;
    bf16x8 vcur[DV / 32];
    if (PFV) {
#pragma unroll
        for (int dt = 0; dt < DV / 32; ++dt) { const s16x4 lo = tr_read(vb + dt * 64), hi = tr_read(vb + 8 * VP + dt * 64); vcur[dt] = __builtin_shufflevector(lo, hi, 0, 1, 2, 3, 4, 5, 6, 7); }
    }
    asm volatile("" ::: "memory");
    if (MASKED) {
#pragma unroll
        for (int i = 0; i < 16; ++i) { const int k0 = crow(i, h); if (!allowed(k0)) s0[i] = NEGBIG; if (!allowed(32 + k0)) s1[i] = NEGBIG; }
    }
    float mxa = max3f(s0[0], s0[1], s1[0]), mxb = max3f(s0[2], s0[3], s1[1]);
    mxa = max3f(mxa, s1[2], s1[3]);
#pragma unroll
    for (int i = 4; i < 16; i += 4) { mxa = max3f(mxa, s0[i], s0[i + 1]); mxb = max3f(mxb, s0[i + 2], s0[i + 3]); mxa = max3f(mxa, s1[i], s1[i + 1]); mxb = max3f(mxb, s1[i + 2], s1[i + 3]); }
    const float mx = xhalf_max(fmaxf(mxa, mxb));
    const float mn = (mx > m + 8.0f) ? mx : m;
    if (__builtin_amdgcn_ballot_w64(mn != m) != 0ull) {
        const float alpha = __builtin_amdgcn_exp2f(m - mn);
        l *= alpha;
#pragma unroll
        for (int dt = 0; dt < DV / 32; ++dt) o[dt] *= alpha;
        m = mn;
    }
    float ps0 = 0.f, ps1 = 0.f;
#pragma unroll
    for (int i = 0; i < 16; ++i) { s0[i] = __builtin_amdgcn_exp2f(s0[i] - mn); s1[i] = __builtin_amdgcn_exp2f(s1[i] - mn); ps0 += s0[i]; ps1 += s1[i]; }
    l += ps0 + ps1;
    bf16x8 pb[4];
#pragma unroll
    for (int s = 0; s < 2; ++s) {
        u32x4 w0, w1;
        w0.x = pk_bf16(s0[8 * s + 0], s0[8 * s + 1]); w0.y = pk_bf16(s0[8 * s + 2], s0[8 * s + 3]); w0.z = pk_bf16(s0[8 * s + 4], s0[8 * s + 5]); w0.w = pk_bf16(s0[8 * s + 6], s0[8 * s + 7]);
        w1.x = pk_bf16(s1[8 * s + 0], s1[8 * s + 1]); w1.y = pk_bf16(s1[8 * s + 2], s1[8 * s + 3]); w1.z = pk_bf16(s1[8 * s + 4], s1[8 * s + 5]); w1.w = pk_bf16(s1[8 * s + 6], s1[8 * s + 7]);
        pb[s] = __builtin_bit_cast(bf16x8, w0); pb[2 + s] = __builtin_bit_cast(bf16x8, w1);
    }
    __builtin_amdgcn_s_setprio(1);
#pragma unroll
    for (int g = 0; g < 4; ++g) {
        bf16x8 vnext[DV / 32];
        if (PFV) {
            if (g < 3) {
#pragma unroll
                for (int dt = 0; dt < DV / 32; ++dt) { const s16x4 lo = tr_read(vb + (16 * (g + 1)) * VP + dt * 64), hi = tr_read(vb + (16 * (g + 1) + 8) * VP + dt * 64); vnext[dt] = __builtin_shufflevector(lo, hi, 0, 1, 2, 3, 4, 5, 6, 7); }
            }
            asm volatile("" ::: "memory");
        } else {
            asm volatile("" ::: "memory");
#pragma unroll
            for (int dt = 0; dt < DV / 32; ++dt) { const s16x4 lo = tr_read(vb + (16 * g) * VP + dt * 64), hi = tr_read(vb + (16 * g + 8) * VP + dt * 64); vcur[dt] = __builtin_shufflevector(lo, hi, 0, 1, 2, 3, 4, 5, 6, 7); }
        }
#pragma unroll
        for (int dt = 0; dt < DV / 32; ++dt) o[dt] = MFMA32(vcur[dt], pb[g], o[dt]);
        if (PFV && g < 3) {
#pragma unroll
            for (int dt = 0; dt < DV / 32; ++dt) vcur[dt] = vnext[dt];
        }
    }
    __builtin_amdgcn_s_setprio(0);
}

template <int NCH, int N>
DI void tile_load(u32x4 (&reg)[N], const bf16_t* src  , int pitch, int tid) {
#pragma unroll
    for (int i = 0; i < N; ++i) { const int c = tid + 512 * i, key = c / NCH, part = c % NCH; const unsigned off = (unsigned)(key * pitch + part * 8) * 2u;
        reg[i] = *(const u32x4*)((const unsigned char*)src + off); }
}
template <int NCH, int N, int PB>
DI void tile_store(const u32x4 (&reg)[N], LAS unsigned char* buf, int tid) {
#pragma unroll
    for (int i = 0; i < N; ++i) { const int c = tid + 512 * i, key = c / NCH, part = c % NCH; *(LAS u32x4*)(buf + key * PB + part * 16) = reg[i]; }
}

template <int DQK, int DV>
DI void causal_attn(LAS unsigned char* lds, const bf16_t* Qp, int qpitch, const bf16_t* Kp, int kpitch, const bf16_t* Vp, int vpitch, int q0, f32x16 (&o)[DV / 32], int tid) {
    constexpr int KP = DQK * 2 + 16, VP = DV * 2 + 64, KBUF = 64 * KP, VBUF = 64 * VP;
    constexpr int KCH = DQK / 8, VCH = DV / 8, KN = 64 * KCH / 512, VN = 64 * VCH / 512;
    LAS unsigned char* Kb = lds; LAS unsigned char* Vb = lds + 2 * KBUF;
    const int lane = tid & 63, w = tid >> 6, r = lane & 31, h = lane >> 5, qw = q0 + 32 * w;
    const int qtrue = qw + r, qrow = qtrue < 0 ? 0 : (qtrue > LROW - 1 ? LROW - 1 : qtrue);
    bf16x8 qf[DQK / 16];
#pragma unroll
    for (int ks = 0; ks < DQK / 16; ++ks) qf[ks] = *(const bf16x8*)(Qp + (size_t)qrow * qpitch + ks * 16 + h * 8);
    float m = NEGBIG, l = 0.f;
#pragma unroll
    for (int dt = 0; dt < DV / 32; ++dt)
#pragma unroll
        for (int i = 0; i < 16; ++i) o[dt][i] = 0.f;
    const int qlast = (q0 + 255 > LROW - 1) ? LROW - 1 : q0 + 255, ktend = qlast >> 6;
    const bool wactive = (qw + 31 >= NFRONT);
    u32x4 kreg[KN], vreg[VN];
    tile_load<KCH, KN>(kreg, Kp + (size_t)64 * kpitch, kpitch, tid); tile_load<VCH, VN>(vreg, Vp + (size_t)64 * vpitch, vpitch, tid);
    tile_store<KCH, KN, KP>(kreg, Kb, tid); tile_store<VCH, VN, VP>(vreg, Vb, tid);
    __syncthreads();
    int cur = 0;
    for (int kt = 1; kt <= ktend; ++kt) {
        if (kt < ktend) { tile_load<KCH, KN>(kreg, Kp + (size_t)(64 * (kt + 1)) * kpitch, kpitch, tid); tile_load<VCH, VN>(vreg, Vp + (size_t)(64 * (kt + 1)) * vpitch, vpitch, tid); }
        if (wactive && 64 * kt <= qw + 31) {
            const LAS unsigned char* Ks = Kb + cur * KBUF; const LAS unsigned char* Vs = Vb + cur * VBUF;
            const int k64 = 64 * kt;
            auto allowed = [&](int slot) { const int kg = k64 + slot; return kg <= qtrue && kg >= NFRONT; };
            if (k64 + 63 > qw || kt == 1) attn_tile<DQK, DV, KP, VP, true>(Ks, Vs, qf, o, m, l, lane, allowed);
            else attn_tile<DQK, DV, KP, VP, false>(Ks, Vs, qf, o, m, l, lane, allowed);
        }
        if (kt < ktend) { tile_store<KCH, KN, KP>(kreg, Kb + (cur ^ 1) * KBUF, tid); tile_store<VCH, VN, VP>(vreg, Vb + (cur ^ 1) * VBUF, tid); }
        __syncthreads();
        cur ^= 1;
    }
    l = xhalf_sum(l);
    const float inv = 1.0f / l;
#pragma unroll
    for (int dt = 0; dt < DV / 32; ++dt) o[dt] *= inv;
}

template <int NDT>
DI void store_oT(bf16_t* dst, const f32x16 (&o)[NDT], int h, bool zero) {
#pragma unroll
    for (int dt = 0; dt < NDT; ++dt)
#pragma unroll
        for (int g = 0; g < 4; ++g) {
            u32x2 w; w.x = pk_bf16(o[dt][4 * g], o[dt][4 * g + 1]); w.y = pk_bf16(o[dt][4 * g + 2], o[dt][4 * g + 3]);
            if (zero) { w.x = 0u; w.y = 0u; }
            *(u32x2*)(dst + 32 * dt + 8 * g + 4 * h) = w;
        }
}

struct AttnL0 { const bf16_t *QA, *KA, *VA, *QM, *KM, *VM; bf16_t* OAB; gcf subln; float lam; };

DI void attn_unit_diff(LAS unsigned char* lds, const AttnL0& A, int b, int hh, int t, int tid) {
    const int lane = tid & 63, w = tid >> 6, r = lane & 31, h = lane >> 5, q0 = 256 * t - 128, qtrue = q0 + 32 * w + r;
    const size_t rb = (size_t)b * LROW;
    const bf16_t* Vp = A.VA + rb * 512 + hh * 128;
    LAS unsigned* o1s = (LAS unsigned*)(lds + 61440) + tid;
    {
        f32x16 o1[4];
        causal_attn<64, 128>(lds, A.QA + rb * 512 + hh * 128 + 64, 512, A.KA + rb * 512 + hh * 128 + 64, 512, Vp, 512, q0, o1, tid);
#pragma unroll
        for (int dt = 0; dt < 4; ++dt)
#pragma unroll
            for (int i = 0; i < 8; ++i) o1s[(dt * 8 + i) * 512] = pk_bf16(o1[dt][2 * i], o1[dt][2 * i + 1]);
    }
    f32x16 o[4];
    causal_attn<64, 128>(lds, A.QA + rb * 512 + hh * 128, 512, A.KA + rb * 512 + hh * 128, 512, Vp, 512, q0, o, tid);
    float ss = 0.f;
#pragma unroll
    for (int dt = 0; dt < 4; ++dt)
#pragma unroll
        for (int i = 0; i < 8; ++i) {
            const unsigned pw = o1s[(dt * 8 + i) * 512];
            const float x0 = o[dt][2 * i] - A.lam * bf_lo(pw), x1 = o[dt][2 * i + 1] - A.lam * bf_hi(pw);
            o[dt][2 * i] = x0; o[dt][2 * i + 1] = x1; ss += x0 * x0 + x1 * x1;
        }
    ss = xhalf_sum(ss);
    const float rs = rsqrtf(ss * (1.0f / 128) + 1e-5f) * 0.8f;
#pragma unroll
    for (int dt = 0; dt < 4; ++dt)
#pragma unroll
        for (int g = 0; g < 4; ++g) { const f32x4 sg = *(const GAS f32x4*)(A.subln + 32 * dt + 8 * g + 4 * h);
#pragma unroll
            for (int e = 0; e < 4; ++e) o[dt][4 * g + e] *= rs * sg[e]; }
    if (qtrue >= 0 && qtrue < LROW) store_oT<4>(A.OAB + (rb + qtrue) * 1024 + hh * 128, o, h, qtrue < NFRONT);
}
DI void attn_unit_mla(LAS unsigned char* lds, const AttnL0& A, int b, int hh, int t, int tid) {
    const int lane = tid & 63, w = tid >> 6, r = lane & 31, h = lane >> 5, q0 = 256 * t - 128, qtrue = q0 + 32 * w + r;
    const size_t rb = (size_t)b * LROW;
    f32x16 o[4];
    causal_attn<192, 128>(lds, A.QM + rb * 768 + hh * 192, 768, A.KM + rb * 768 + hh * 192, 768, A.VM + rb * 512 + hh * 128, 512, q0, o, tid);
    if (qtrue >= 0 && qtrue < LROW) store_oT<4>(A.OAB + (rb + qtrue) * 1024 + 512 + hh * 128, o, h, qtrue < NFRONT);
}

struct AttnL1 { const bf16_t *QS, *KS, *VS; bf16_t* OS; gcf sinks; };
DI void attn_unit_swa(LAS unsigned char* lds, const AttnL1& A, int b, int kvh, int n, int tid) {
    constexpr int KP = 144, VP = 192, NROW = 320;
    LAS unsigned char* Kb = lds; LAS unsigned char* Vb = lds + NROW * KP;
    const size_t rb = (size_t)b * LROW;
    for (int c = tid; c < NROW * 8; c += 512) {
        const int j = c >> 3, part = c & 7;
        int gr = (j < 256) ? 128 * (n - 1) + j : ((j < 272) ? NFRONT + (j - 256) : -1);
        u32x4 kv = {0u, 0u, 0u, 0u}, vv = {0u, 0u, 0u, 0u};
        if (gr >= 0) { kv = *(const u32x4*)(A.KS + (rb + gr) * 128 + kvh * 64 + part * 8); vv = *(const u32x4*)(A.VS + (rb + gr) * 128 + kvh * 64 + part * 8); }
        *(LAS u32x4*)(Kb + j * KP + part * 16) = kv; *(LAS u32x4*)(Vb + j * VP + part * 16) = vv;
    }
    __syncthreads();
    const int lane = tid & 63, g = tid >> 6, r = lane & 31, h = lane >> 5, head = kvh * 8 + g;
    const float sink = A.sinks[head] * LOG2E;
    for (int j = 0; j < 4; ++j) {
        const int qtrue = 128 * n + 32 * j + r;
        bf16x8 qf[4];
#pragma unroll
        for (int ks = 0; ks < 4; ++ks) qf[ks] = *(const bf16x8*)(A.QS + (rb + qtrue) * 1024 + head * 64 + ks * 16 + h * 8);
        float m = sink, l = (h == 0) ? 1.0f : 0.0f;
        f32x16 o[2];
#pragma unroll
        for (int dt = 0; dt < 2; ++dt)
#pragma unroll
            for (int i = 0; i < 16; ++i) o[dt][i] = 0.f;
        const int tb0 = (j < 2) ? 0 : 1;
        for (int tb = tb0; tb < tb0 + 3; ++tb) {
            const int kbase = 128 * (n - 1) + 64 * tb;
            auto allowed = [&](int slot) { const int kg = kbase + slot; return kg <= qtrue && kg >= NFRONT && (kg < 128 || qtrue - kg < 128); };
            attn_tile<64, 64, KP, VP, true>(Kb + 64 * tb * KP, Vb + 64 * tb * VP, qf, o, m, l, lane, allowed);
        }
        if (n >= 2) {
            auto allowed = [&](int slot) { return slot < 16; };
            attn_tile<64, 64, KP, VP, true>(Kb + 256 * KP, Vb + 256 * VP, qf, o, m, l, lane, allowed);
        }
        l = xhalf_sum(l);
        const float inv = 1.0f / l;
#pragma unroll
        for (int dt = 0; dt < 2; ++dt) o[dt] *= inv;
        store_oT<2>(A.OS + (rb + qtrue) * 1024 + head * 64, o, h, qtrue < NFRONT);
    }
    __syncthreads();
}
#define XB_TMO      128
#define XB_XCNT(j)  (256  + 64 * (j))
#define XB_XSUB(j)  (1280 + 64 * (j))
#define XB_XGEN(j)  (2304 + 64 * (j))
#define XB_TOP      3328
#define XB_TOPGEN   3392
#define XCD_BAR_WORDS 3456
#define XB_SPIN_CAP (1u << 18)

__device__ __forceinline__ unsigned xb_ld(unsigned* p)              { return __hip_atomic_load(p, __ATOMIC_RELAXED, __HIP_MEMORY_SCOPE_AGENT); }
__device__ __forceinline__ unsigned xb_add(unsigned* p, unsigned v) { return __hip_atomic_fetch_add(p, v, __ATOMIC_RELAXED, __HIP_MEMORY_SCOPE_AGENT); }
__device__ __forceinline__ unsigned xb_xcc_id() { return (unsigned)__builtin_amdgcn_s_getreg((3 << 11) | 20) & 0xFu; }
#define XB_SPIN(cond, bar) do { unsigned _sp = 0; while (cond) { __builtin_amdgcn_s_sleep(1); \
    if ((++_sp & 255u) == 0u) { if (xb_ld(&(bar)[XB_TMO])) break; if (_sp > XB_SPIN_CAP) { atomicAdd(&(bar)[XB_TMO], 1u); break; } } } } while (0)

struct XcdBarrier {
    unsigned* bar; unsigned x;
    volatile LAS unsigned* st;
};

__device__ __forceinline__ XcdBarrier xcd_barrier_post(unsigned* bar, volatile LAS unsigned* st) {
    XcdBarrier b; b.bar = bar; b.x = xb_xcc_id(); b.st = st;
    if (threadIdx.x == 0) (void)xb_add(&bar[XB_XCNT(b.x)], 1u);
    return b;
}
__device__ __forceinline__ void xcd_barrier_complete(unsigned* bar, unsigned x, unsigned& nloc, unsigned& nx) {
    const unsigned G = gridDim.x * gridDim.y * gridDim.z;
    unsigned sum, cnt, mine, sp = 0u;
    for (;;) {
        sum = 0u; cnt = 0u; mine = 0u;
#pragma unroll
        for (unsigned j = 0; j < 16; ++j) { const unsigned c = xb_ld(&bar[XB_XCNT(j)]); sum += c; cnt += (c > 0u) ? 1u : 0u; mine = (j == x) ? c : mine; }
        if (sum == G) break;
        __builtin_amdgcn_s_sleep(1);
        if ((++sp & 255u) == 0u) { if (xb_ld(&bar[XB_TMO])) break; if (sp > XB_SPIN_CAP) { atomicAdd(&bar[XB_TMO], 1u); break; } }
    }
    nloc = mine > 0u ? mine : 1u; nx = cnt > 0u ? cnt : 1u;
}

__device__ __forceinline__ void xcd_barrier(const XcdBarrier& b) {
    asm volatile("s_waitcnt vmcnt(0)" ::: "memory");
    __syncthreads();
    if (threadIdx.x == 0) {
        unsigned* bar = b.bar;
        __builtin_amdgcn_s_waitcnt(0);
        unsigned nloc = b.st[0], nx = b.st[1];
        if (nloc == 0u) { xcd_barrier_complete(bar, b.x, nloc, nx); b.st[0] = nloc; b.st[1] = nx; }
        const unsigned old = xb_add(&bar[XB_XSUB(b.x)], 1u);
        const unsigned gen = old / nloc;
        if (old + 1u == (gen + 1u) * nloc) {
            __builtin_amdgcn_fence(__ATOMIC_RELEASE, "agent");
            asm volatile("s_waitcnt vmcnt(0)" ::: "memory");
            const unsigned og = xb_add(&bar[XB_TOP], 1u);
            const unsigned tg = og / nx;
            if (og + 1u == (tg + 1u) * nx) xb_add(&bar[XB_TOPGEN], 1u);
            else XB_SPIN(xb_ld(&bar[XB_TOPGEN]) == tg, bar);
            __builtin_amdgcn_fence(__ATOMIC_ACQUIRE, "agent");
            xb_add(&bar[XB_XGEN(b.x)], 1u);
            asm volatile("s_waitcnt vmcnt(0)" ::: "memory");
        } else {
            XB_SPIN(xb_ld(&bar[XB_XGEN(b.x)]) == gen, bar);
            __builtin_amdgcn_fence(__ATOMIC_ACQUIRE, "agent");
            asm volatile("s_waitcnt vmcnt(0)" ::: "memory");
        }
    }
    __syncthreads();
}

DI int srccol(int kind, int nd) {
    if (kind == 1) return 128 * (nd >> 8) + (nd & 127);
    if (kind == 2) { if (nd < 1024) return (nd & ~63) + permP(nd & 63); if (nd < 2048) return nd; if (nd < 2112) return 2048 + permM(nd - 2048); return -1; }
    if (kind == 3) { const int hh = nd / 192, d = nd % 192; return hh * 192 + (d < 128 ? d : 128 + permM(d - 128)); }
    if (kind == 4) { if (nd < 1152) return (nd & ~63) + permP(nd & 63); return nd; }
    return nd;
}
DI void wt_item(gcf W, int ldw, int nsrc, int Kdim, int k0, int n0, int kind, gcf gain, bf16_t* WT, LAS float* scr, int lane) {
    const int sbase = (kind == 1) ? 128 * (n0 >> 8) : n0;
    const int c4 = (lane & 31) * 4;
    const bool okc = sbase + c4 < nsrc;
    f32x4 v[16];
#pragma unroll
    for (int i = 0; i < 16; ++i) {
        const int kk = 2 * i + (lane >> 5);
        v[i] = (f32x4){0.f, 0.f, 0.f, 0.f};
        if (okc) v[i] = *(const GAS f32x4*)(W + (size_t)(k0 + kk) * ldw + sbase + c4);
    }
#pragma unroll
    for (int i = 0; i < 16; ++i) {
        const int kk = 2 * i + (lane >> 5);
        if (gain) v[i] *= gain[k0 + kk];
        *(LAS f32x4*)(scr + kk * 132 + c4) = v[i];
    }
    asm volatile("s_waitcnt lgkmcnt(0)" ::: "memory");
    const int kq = lane >> 4;
#pragma unroll
    for (int j = 0; j < 8; ++j) {
        const int n = (lane & 15) + 16 * j;
        const int sc = srccol(kind, n0 + n);
        u32x4 o = {0u, 0u, 0u, 0u};
        if (sc >= 0) { const LAS float* s = scr + (8 * kq) * 132 + (sc - sbase);
            o.x = pk_bf16(s[0 * 132], s[1 * 132]); o.y = pk_bf16(s[2 * 132], s[3 * 132]); o.z = pk_bf16(s[4 * 132], s[5 * 132]); o.w = pk_bf16(s[6 * 132], s[7 * 132]); }
        *(u32x4*)(WT + (size_t)(n0 + n) * Kdim + k0 + 8 * kq) = o;
    }
    asm volatile("s_waitcnt lgkmcnt(0)" ::: "memory");
}
constexpr int I_GU = 32 * 44, I_DN = 88 * 8, I_FFN = I_GU + I_DN, I_WIN = 32 * 18, I_UQ = 8 * 6, I_UKV = 8 * 8, I_WO = 32 * 8, I_QKV = 32 * 10;
constexpr int W_ITEMS_L0 = 2 * I_FFN + I_WIN + I_UQ + I_UKV + I_WO, W_ITEMS = W_ITEMS_L0 + 2 * I_FFN + I_QKV + I_WO;
DI void convert_weights(unsigned char* ws, LAS unsigned char* lds, int tid, int it_lo, int it_hi, int gw, int NGW) {
    const int lane = tid & 63, wave = tid >> 6;
    LAS float* scr = (LAS float*)(lds + wave * 16896);
    bf16_t* WB = (bf16_t*)(ws + WS_W);
    for (int it = it_lo + gw; it < it_hi; it += NGW) {
        int r = it, lyr = 0;
        if (r >= W_ITEMS_L0) { r -= W_ITEMS_L0; lyr = 1; }
        if (r < 2 * I_FFN) {
            const int f = r / I_FFN, fi = 2 * lyr + f; r %= I_FFN;
            if (r < I_GU) {
                const int kb = r / 44, n0 = (r % 44) * 128;
                gcf W = (((n0 & 255) < 128) ? (f ? INP(24) : INP(3)) : (f ? INP(25) : INP(4))) + (size_t)lyr * D * FF;
                wt_item(W, FF, FF, D, kb * 32, n0, 1, (f ? INP(23) : INP(2)) + lyr * D, WB + WOFF_FFN + (size_t)fi * (W_GU + W_DN), scr, lane);
            } else {
                r -= I_GU;
                wt_item((f ? INP(26) : INP(5)) + (size_t)lyr * FF * D, D, D, FF, (r / 8) * 32, (r % 8) * 128, 0, nullptr, WB + WOFF_FFN + (size_t)fi * (W_GU + W_DN) + W_GU, scr, lane);
            }
            continue;
        }
        r -= 2 * I_FFN;
        if (lyr == 0) {
            if (r < I_WIN) { wt_item(INP(7), 2112, 2112, D, (r / 18) * 32, (r % 18) * 128, 2, INP(6), WB + WOFF_WIN, scr, lane); continue; } r -= I_WIN;
            if (r < I_UQ) { wt_item(INP(14), 768, 768, 256, (r / 6) * 32, (r % 6) * 128, 3, INP(13), WB + WOFF_UQ, scr, lane); continue; } r -= I_UQ;
            if (r < I_UKV) { wt_item(INP(16), 1024, 1024, 256, (r / 8) * 32, (r % 8) * 128, 0, INP(15), WB + WOFF_UKV, scr, lane); continue; } r -= I_UKV;
            wt_item(INP(17), 1024, 1024, D, (r / 8) * 32, (r % 8) * 128, 0, nullptr, WB + WOFF_WO0, scr, lane);
        } else {
            if (r < I_QKV) { wt_item(INP(18), 1280, 1280, D, (r / 10) * 32, (r % 10) * 128, 4, INP(6) + D, WB + WOFF_QKV, scr, lane); continue; } r -= I_QKV;
            wt_item(INP(21), 1024, 1024, D, (r / 8) * 32, (r % 8) * 128, 0, nullptr, WB + WOFF_WO1, scr, lane);
        }
    }
}

DI void prologue(const Args& a, LAS unsigned char* lds, int tid) {
    const int lane = tid & 63, wave = tid >> 6;
    const int gt = blockIdx.x * 512 + tid, nthr = gridDim.x * 512;
    const int gw = blockIdx.x * 8 + wave, NGW = gridDim.x * 8;
    float* ssq = (float*)(a.ws + WS_SSQ);
    for (int i = gt; i < 8 * R; i += nthr) ssq[R + i] = 0.f;
    if (gt < 256) ((unsigned*)(a.ws + WS_CTL))[gt] = 0u;
    {
        float2* tabP = (float2*)(a.ws + WS_TABP); float2* tabM = (float2*)(a.ws + WS_TABM);
        for (int e = gt; e < NPOS * 40; e += nthr) {
            const int pos = e / 40, i = e % 40;
            const double ex = (i < 8) ? (double)(2 * i) / 16.0 : (double)(2 * (i - 8)) / 64.0;
            const double inv = exp2(-ex * 18.931568569324174);
            double rev = (double)pos * inv * 0.15915494309189535;
            rev -= floor(rev);
            const float f = (float)rev;
            const float2 cs = make_float2(__builtin_amdgcn_cosf(f), __builtin_amdgcn_sinf(f));
            if (i < 8) tabP[pos * 8 + i] = cs; else tabM[pos * 32 + (i - 8)] = cs;
        }
    }
    { float* bp = (float*)(a.ws + WS_BQKV); gcf bq = INP(19); for (int i = gt; i < NQKV; i += nthr) bp[i] = bq[srccol(4, i)]; }
    {
        float* H = (float*)(a.ws + WS_H); bf16_t* HB = (bf16_t*)(a.ws + WS_HB);
        for (int row = gw; row < R; row += NGW) {
            const int b = row / LROW, i = row % LROW;
            gcf src = (i < NFRONT) ? nullptr : (i < 128 ? INP(1) + (size_t)(i - NFRONT) * D : INP(0) + ((size_t)b * SEQ + (i - 128)) * D);
            float s = 0.f;
#pragma unroll
            for (int j = 0; j < 4; ++j) {
                f32x4 v = {0.f, 0.f, 0.f, 0.f};
                if (src) v = *(const GAS f32x4*)(src + 256 * j + 4 * lane);
                *(f32x4*)(H + (size_t)row * D + 256 * j + 4 * lane) = v;
                u32x2 w; w.x = pk_bf16(v[0], v[1]); w.y = pk_bf16(v[2], v[3]);
                *(u32x2*)(HB + (size_t)row * D + 256 * j + 4 * lane) = w;
                s += (v[0] * v[0] + v[1] * v[1]) + (v[2] * v[2] + v[3] * v[3]);
            }
            s = wave_sum(s);
            if (lane == 0) ssq[row] = s;
        }
    }
    convert_weights(a.ws, lds, tid, 0, W_ITEMS_L0, gw, NGW);
}

constexpr int NPH_ = 23;
__global__ void __launch_bounds__(512, 2) fwd(Args a) {
    extern __shared__ __attribute__((aligned(16))) unsigned char lds_raw[];
    LAS unsigned char* lds = (LAS unsigned char*)lds_raw;
    volatile LAS unsigned* misc = (volatile LAS unsigned*)(lds + LDS_MISC);
    cg::grid_group grid = cg::this_grid();
    volatile LAS unsigned* xst = (volatile LAS unsigned*)(lds + 147392);
    if (threadIdx.x == 0) { xst[0] = 0u; xst[1] = 0u; }
    __syncthreads();
    if (a.ph_lo == 0 && a.ph_hi == NPH_) (void)xcd_barrier_post((unsigned*)(a.ws + WS_CTL) + 4096, xst);
    int tid = threadIdx.x, bid = blockIdx.x;
    unsigned char* ws = a.ws;
#define ssq ((float*)(ws + WS_SSQ))
#define H ((float*)(ws + WS_H))
#define HB ((bf16_t*)(ws + WS_HB))
#define ACT ((bf16_t*)(ws + WS_ACT))
#define WB ((bf16_t*)(ws + WS_W))
#define tabP ((const float2*)(ws + WS_TABP))
#define tabM ((const float2*)(ws + WS_TABM))
#define QA ((bf16_t*)(ws + WS_QA))
#define KA ((bf16_t*)(ws + WS_KA))
#define VA ((bf16_t*)(ws + WS_VA))
#define QM ((bf16_t*)(ws + WS_QM))
#define CQ ((bf16_t*)(ws + WS_CQ))
#define CKV ((bf16_t*)(ws + WS_CKV))
#define KM ((bf16_t*)(ws + WS_KM))
#define OAB ((bf16_t*)((unsigned char*)a.out + OUT_OAB))
#define VM ((bf16_t*)((unsigned char*)a.out + OUT_VM))
#define QS ((bf16_t*)(ws + WS_QS))
#define KS ((bf16_t*)(ws + WS_KS))
#define VS ((bf16_t*)(ws + WS_VS))
#define OS ((bf16_t*)(ws + WS_OS))
    const int lo = a.ph_lo, hi = a.ph_hi;
#define IN(k) (lo <= (k) && (k) < hi)
#define REPS(k)
#define SEAM(k) do { if (IN(k) && IN((k) + 1)) { if (!(lo == 0 && hi == NPH_)) grid.sync(); else { XcdBarrier xb_; xb_.bar = (unsigned*)(a.ws + WS_CTL) + 4096; xb_.x = xb_xcc_id(); xb_.st = xst; xcd_barrier(xb_); } } } while (0)
#define RUN_GEMM(EpiT, E, Aptr, Bptr, N_, K_) do { int k_rt = (K_); asm volatile("" : "+s"(k_rt)); pg8::Gemm g{(Aptr), (Bptr), R, (N_), k_rt}; pg8::StaticOrder S; S.init(R, (N_), (int)gridDim.x, bid); \
        pg8::gemm_phase<EpiT, pg8::StaticOrder, true, true>(lds, g, S, (E)); } while (0)

#define LAUNDER_TID() do { tid = threadIdx.x; asm volatile("" : "+v"(tid)); { size_t z_ = 0; asm volatile("" : "+s"(z_)); ws = a.ws + z_; } bid = blockIdx.x; asm volatile("" : "+s"(bid)); } while (0)
#define RUN_RESID(E_, Aptr, Bptr, K_) do { int k_rt = (K_); asm volatile("" : "+s"(k_rt)); \
        pg8::StaticOrder S0; S0.init(R, D, (int)gridDim.x, bid); const int G_ = (int)gridDim.x, cap_ = (S0.nwg / G_) * G_, nleft_ = S0.nwg - cap_; \
        { pg8::Gemm g{(Aptr), (Bptr), R, D, k_rt, 0}; pg8::CapOrder S; S.init(R, D, G_, bid, cap_); pg8::gemm_phase<EpiResid, pg8::CapOrder, true, true>(lds, g, S, (E_)); } \
        { const int NS_ = k_rt >> 8; \
          for (int j_ = bid; j_ < nleft_ * NS_; j_ += G_) { const int e_ = j_ / NS_, sl_ = j_ % NS_; pg8::OneUnit S1; pg8::CapOrder::unit_of(S0, cap_ + e_, S1.u); \
              int nt_rt = 4; asm volatile("" : "+s"(nt_rt)); pg8::Gemm g{(Aptr) + sl_ * 256, (Bptr) + sl_ * 256, R, D, k_rt, nt_rt}; EpiPartial EA{(unsigned char*)a.out, e_, sl_}; pg8::gemm_phase<EpiPartial, pg8::OneUnit, true, true>(lds, g, S1, EA); } } } while (0)
#define RUN_FIXUP(ssq_idx_, has_bias_, alpha_, NS_) do { pg8::StaticOrder S0; S0.init(R, D, (int)gridDim.x, bid); const int G_ = (int)gridDim.x, cap_ = (S0.nwg / G_) * G_, nleft_ = S0.nwg - cap_; \
        const int lane_ = tid & 63; float* ssqo_ = ssq + (size_t)(ssq_idx_) * R; \
        for (int idx_ = bid * 8 + (tid >> 6); idx_ < nleft_ * 256; idx_ += G_ * 8) { const int e_ = idx_ >> 8, rl_ = idx_ & 255; pg8::Unit u_; pg8::CapOrder::unit_of(S0, cap_ + e_, u_); \
            const int row_ = u_.pm * 256 + rl_, c_ = u_.pn * 256 + lane_ * 4; const float* sp_ = (const float*)((unsigned char*)a.out + OUT_SPLIT) + (size_t)e_ * 11 * 65536 + rl_ * 256 + lane_ * 4; \
            f32x4 acc_ = *(const f32x4*)sp_; \
            _Pragma("unroll") for (int s_ = 1; s_ < (NS_); ++s_) acc_ += *(const f32x4*)(sp_ + (size_t)s_ * 65536); \
            f32x4 h4_ = *(const f32x4*)(H + (size_t)row_ * D + c_) + acc_ * (alpha_); \
            if (has_bias_) h4_ += *(const GAS f32x4*)(INP(22) + c_); \
            *(f32x4*)(H + (size_t)row_ * D + c_) = h4_; u32x2 w_; w_.x = pk_bf16(h4_[0], h4_[1]); w_.y = pk_bf16(h4_[2], h4_[3]); *(u32x2*)(HB + (size_t)row_ * D + c_) = w_; \
            const float ss_ = wave_sum((h4_[0] * h4_[0] + h4_[1] * h4_[1]) + (h4_[2] * h4_[2] + h4_[3] * h4_[3])); if (lane_ == 0) atomicAdd(ssqo_ + row_, ss_); } } while (0)
    if (IN(0)) { LAUNDER_TID(); REPS(0) { prologue(a, lds, tid); __syncthreads(); } }
    SEAM(0);
    int ph = 1;
    for (int l = 0; l < 2; ++l) {
        const bf16_t* Wgu1 = WB + WOFF_FFN + (size_t)(2 * l) * (W_GU + W_DN);
        if (IN(ph)) { LAUNDER_TID(); EpiSwiglu E{ws, 3 * l}; REPS(ph) RUN_GEMM(EpiSwiglu, E, HB, Wgu1, 5632, D); }
        SEAM(ph); ++ph;
        if (IN(ph)) { LAUNDER_TID(); EpiResid E{ws, 3 * l + 1, 0, 0.5f}; RUN_RESID(E, ACT, Wgu1 + W_GU, FF);
            if (l == 0) convert_weights(ws, lds, tid, W_ITEMS_L0, W_ITEMS, bid * 8 + (tid >> 6), (int)gridDim.x * 8); }
        SEAM(ph); ++ph;
        if (IN(ph)) { LAUNDER_TID(); RUN_FIXUP(3 * l + 1, 0, 0.5f, 11); }
        SEAM(ph); ++ph;
        if (l == 0) {
            if (IN(ph)) { LAUNDER_TID(); EpiWin E{ws, 0.125f * LOG2E}; RUN_GEMM(EpiWin, E, HB, WB + WOFF_WIN, NWIN, D); }
            SEAM(ph); ++ph;
            if (IN(ph)) { LAUNDER_TID();
                REPS(ph) { EpiUq E{ws, 0.07216878364870322f * LOG2E}; RUN_GEMM(EpiUq, E, CQ, WB + WOFF_UQ, NUQ, 256); }
                REPS(ph) { EpiUkv E{ws, (unsigned char*)a.out}; RUN_GEMM(EpiUkv, E, CKV, WB + WOFF_UKV, NUKV, 256); }
            }
            SEAM(ph); ++ph;
            if (IN(ph)) { LAUNDER_TID();
                LAUNDER_TID();
                if (tid < 64) {
                    const float s1 = wave_sum(INP(8)[tid] * INP(9)[tid]), s2 = wave_sum(INP(10)[tid] * INP(11)[tid]);
                    if (tid == 0) misc[1] = __float_as_uint(__expf(s1) - __expf(s2) + 0.2f);
                }
                __syncthreads();
                AttnL0 A{QA, KA, VA, QM, KM, VM, OAB, INP(12), __uint_as_float(misc[1])};
                unsigned* qctr = (unsigned*)(ws + WS_CTL);
                REPS(ph) {
                for (;;) {
                    if (tid == 0) misc[0] = atomicAdd(qctr, 1u);
                    __syncthreads();
                    const unsigned idx = misc[0];
                    __syncthreads();
                    if (idx >= 33u * 16u) break;
                    const int t = 32 - (int)(idx >> 4), rem = idx & 15;
                    attn_unit_diff(lds, A, rem & 3, rem >> 2, t, tid);
                }
                asm volatile("" ::: "memory");
                for (;;) {
                    if (tid == 0) misc[0] = atomicAdd(qctr + 64, 1u);
                    __syncthreads();
                    const unsigned idx = misc[0];
                    __syncthreads();
                    if (idx >= 33u * 16u) break;
                    const int t = 32 - (int)(idx >> 4), rem = idx & 15;
                    attn_unit_mla(lds, A, rem & 3, rem >> 2, t, tid);
                }
                }
            }
            SEAM(ph); ++ph;
            if (IN(ph)) { LAUNDER_TID(); EpiResid E{ws, 2, 0, 1.0f}; RUN_RESID(E, OAB, WB + WOFF_WO0, D); }
            SEAM(ph); ++ph;
            if (IN(ph)) { LAUNDER_TID(); RUN_FIXUP(2, 0, 1.0f, 4); }
            SEAM(ph); ++ph;
        } else {
            if (IN(ph)) { LAUNDER_TID(); EpiQkvS E{ws, 0.125f * LOG2E}; RUN_GEMM(EpiQkvS, E, HB, WB + WOFF_QKV, NQKV, D); }
            SEAM(ph); ++ph;
            if (IN(ph)) { LAUNDER_TID();
                LAUNDER_TID();
                AttnL1 A{QS, KS, VS, OS, INP(20)};
                REPS(ph) for (int u = bid; u < NB * 2 * 65; u += gridDim.x) { const int b = u / 130, rem = u % 130; attn_unit_swa(lds, A, b, rem / 65, rem % 65, tid); }
            }
            SEAM(ph); ++ph;
            if (IN(ph)) { LAUNDER_TID(); EpiResid E{ws, 5, 1, 1.0f}; RUN_RESID(E, OS, WB + WOFF_WO1, D); }
            SEAM(ph); ++ph;
            if (IN(ph)) { LAUNDER_TID(); RUN_FIXUP(5, 1, 1.0f, 4); }
            SEAM(ph); ++ph;
        }
        const bf16_t* Wgu2 = WB + WOFF_FFN + (size_t)(2 * l + 1) * (W_GU + W_DN);
        if (IN(ph)) { LAUNDER_TID(); EpiSwiglu E{ws, 3 * l + 2}; REPS(ph) RUN_GEMM(EpiSwiglu, E, HB, Wgu2, 5632, D); }
        SEAM(ph); ++ph;
        if (IN(ph)) { LAUNDER_TID(); EpiResid E{ws, 3 * l + 3, 0, 0.5f}; RUN_RESID(E, ACT, Wgu2 + W_GU, FF); }
        SEAM(ph); ++ph;
        if (IN(ph)) { LAUNDER_TID(); RUN_FIXUP(3 * l + 3, 0, 0.5f, 11); }
        SEAM(ph); ++ph;
    }
    if (IN(ph)) { LAUNDER_TID();
        LAUNDER_TID();
        const int lane = tid & 63, gw = bid * 8 + (tid >> 6), NGW = gridDim.x * 8;
        gcf gf = INP(27);
        REPS(ph) for (int s = gw; s < NB * SEQ; s += NGW) {
            const int row = (s / SEQ) * LROW + 128 + (s % SEQ);
            const float rstd = rsqrtf(ssq[(size_t)6 * R + row] * (1.0f / D) + EPS);
#pragma unroll
            for (int j = 0; j < 4; ++j) {
                const f32x4 v = *(const f32x4*)(H + (size_t)row * D + 256 * j + 4 * lane), gg = *(const GAS f32x4*)(gf + 256 * j + 4 * lane);
                *(f32x4*)(a.out + (size_t)s * D + 256 * j + 4 * lane) = v * rstd * gg;
            }
        }
    }
}
constexpr int NPH = 23;

extern "C" void kernel_launch(void* const* d_in, const int* in_sizes, int n_in, void* d_out, int out_size, void* d_ws, size_t ws_size, hipStream_t stream) {
    static int grid = 0;
    if (grid == 0) {
        if (n_in != 28 || out_size != NB * SEQ * D || ws_size < WS_END) { fprintf(stderr, "kernel_launch: unexpected problem (n_in %d out %d ws %zu)\n", n_in, out_size, ws_size); grid = -1; return; }
        int dev = 0, cus = 0, per = 0;
        (void)hipGetDevice(&dev); (void)hipDeviceGetAttribute(&cus, hipDeviceAttributeMultiprocessorCount, dev);
        (void)hipFuncSetAttribute((const void*)fwd, hipFuncAttributeMaxDynamicSharedMemorySize, LDS_BYTES);
        (void)hipOccupancyMaxActiveBlocksPerMultiprocessor(&per, (const void*)fwd, 512, LDS_BYTES);
        (void)hipGetLastError();
        grid = cus > 0 ? cus : 256;
    }
    if (grid < 0) return;
    Args a{};
    for (int i = 0; i < 28; ++i) a.in[i] = (const float*)d_in[i];
    a.out = (float*)d_out; a.ws = (unsigned char*)d_ws;
#if MK_PER_PHASE
    for (int p = 0; p < NPH; ++p) {
        const int reps = ((PROBE_MASK >> p) & 1u) ? PROBE_N : 1;
        for (int r = 0; r < reps; ++r) {
            if (p == 6 && r > 0) (void)hipMemsetAsync(d_ws, 0, 1024, stream);
            a.ph_lo = p; a.ph_hi = p + 1; hipLaunchKernelGGL(fwd, dim3(grid), dim3(512), LDS_BYTES, stream, a);
        }
    }
#else
    a.ph_lo = 0; a.ph_hi = NPH;
    (void)hipMemsetAsync((char*)d_ws + WS_CTL + 4096 * 4, 0, XCD_BAR_WORDS * 4, stream);
    void* args[] = {&a};
    hipError_t e = hipLaunchCooperativeKernel((const void*)fwd, dim3(grid), dim3(512), args, LDS_BYTES, stream);
    if (e != hipSuccess) fprintf(stderr, "cooperative launch failed: %s (grid %d)\n", hipGetErrorString(e), grid);
#endif
}
```
